# Optimizing an MI355X kernel written in HIP

```python
import jax, jax.numpy as jnp
from jax import lax
import numpy as np

D_MODEL = 2048
BATCH = 8
SEQ = 2048
DEPTH = 4

N_MIXERS = 3
GRID_W = 64
HEAD_DIM = 128
EPS = 1e-6
NEG_INF = -1e30
NA_HEADS = D_MODEL // HEAD_DIM
NA_WIN_R = 8
NA_WIN_C = 16
SC_WIDTH = 3
GQA_Q_HEADS = D_MODEL // HEAD_DIM
GQA_KV_HEADS = GQA_Q_HEADS // 4
GQA_GROUP = GQA_Q_HEADS // GQA_KV_HEADS
Q_BLOCK = 128
ROPE_THETA = 10000.0
D_FF = ((8 * D_MODEL // 3 + 255) // 256) * 256
FFN_CONV_WIDTH = 3

kernel_name = "hybrid_natten_shortconv_gqa_convffn_encoder"


def rms_norm(x, g):
    xf = x.astype(jnp.float32)
    y = xf * lax.rsqrt(jnp.mean(xf * xf, axis=-1, keepdims=True) + EPS)
    return (y * g.astype(jnp.float32)).astype(x.dtype)


def dwconv_centered(x, w):
    k = w.shape[0]
    pad = k // 2
    s = x.shape[1]
    xp = jnp.pad(x, ((0, 0), (pad, k - 1 - pad), (0, 0)))
    out = xp[:, 0:s] * w[0]
    for i in range(1, k):
        out = out + xp[:, i:i + s] * w[i]
    return out


def neighborhood_attention(x, w_qkv, rpb, w_o):
    b, s, _ = x.shape
    rows = s // GRID_W
    wr = min(NA_WIN_R, rows)
    q, k, v = jnp.split(x @ w_qkv, 3, axis=-1)
    grid = lambda t: t.reshape(b, rows, GRID_W, NA_HEADS, HEAD_DIM)
    q = grid(q) * (HEAD_DIM ** -0.5)
    k, v = grid(k), grid(v)
    cols = jnp.arange(GRID_W)
    c_start = jnp.clip(cols - NA_WIN_C // 2, 0, GRID_W - NA_WIN_C)
    col_valid = (cols[None, :] >= c_start[:, None]) & (cols[None, :] < c_start[:, None] + NA_WIN_C)
    dc = jnp.clip(cols[None, :] - cols[:, None] + NA_WIN_C - 1, 0, 2 * NA_WIN_C - 2)
    rpb_cols = rpb[:, :, dc]

    def row_block(r):
        r_start = jnp.clip(r - NA_WIN_R // 2, 0, rows - wr)
        k_r = lax.dynamic_slice_in_dim(k, r_start, wr, axis=1)
        v_r = lax.dynamic_slice_in_dim(v, r_start, wr, axis=1)
        q_r = lax.dynamic_index_in_dim(q, r, axis=1, keepdims=False)
        dr = r_start + jnp.arange(wr) - r + NA_WIN_R - 1
        bias = jnp.transpose(rpb_cols[:, dr], (0, 2, 1, 3))
        sc = jnp.einsum('bqhd,bikhd->bhqik', q_r, k_r, preferred_element_type=jnp.float32)
        sc = sc + bias[None].astype(jnp.float32)
        sc = jnp.where(col_valid[:, None, :], sc, NEG_INF)
        p = jax.nn.softmax(sc.reshape(b, NA_HEADS, GRID_W, wr * GRID_W), axis=-1)
        p = p.reshape(b, NA_HEADS, GRID_W, wr, GRID_W).astype(v.dtype)
        return jnp.einsum('bhqik,bikhd->bqhd', p, v_r)

    out = lax.map(row_block, jnp.arange(rows))
    out = jnp.transpose(out, (1, 0, 2, 3, 4)).reshape(b, s, NA_HEADS * HEAD_DIM)
    return out @ w_o


def short_conv_mixer(x, w_in, conv_w, w_out):
    gb, gc, h = jnp.split(x @ w_in, 3, axis=-1)
    return (gb * dwconv_centered(gc * h, conv_w)) @ w_out


def axial_rope_tables(s):
    t = jnp.arange(s)
    row = (t // GRID_W).astype(jnp.float32)[:, None]
    col = (t % GRID_W).astype(jnp.float32)[:, None]
    half = HEAD_DIM // 2
    inv = ROPE_THETA ** (-jnp.arange(0, half, 2, dtype=jnp.float32) / half)
    ang = jnp.concatenate([row * inv, row * inv, col * inv, col * inv], axis=-1)
    return jnp.cos(ang), jnp.sin(ang)


def rotate_half_axial(x):
    lead = x.shape[:-1]
    xs = x.reshape(*lead, 2, 2, HEAD_DIM // 4)
    x1, x2 = xs[..., 0, :], xs[..., 1, :]
    return jnp.stack([-x2, x1], axis=-2).reshape(*lead, HEAD_DIM)


def apply_axial_rope(x, cos, sin):
    xf = x.astype(jnp.float32)
    return (xf * cos[:, None, :] + rotate_half_axial(xf) * sin[:, None, :]).astype(x.dtype)


def gqa_axial_attention(x, w_qkv, q_norm, k_norm, w_o):
    b, s, _ = x.shape
    qkv = x @ w_qkv
    nq = GQA_Q_HEADS * HEAD_DIM
    nk = GQA_KV_HEADS * HEAD_DIM
    q = qkv[..., :nq].reshape(b, s, GQA_Q_HEADS, HEAD_DIM)
    k = qkv[..., nq:nq + nk].reshape(b, s, GQA_KV_HEADS, HEAD_DIM)
    v = qkv[..., nq + nk:].reshape(b, s, GQA_KV_HEADS, HEAD_DIM)
    cos, sin = axial_rope_tables(s)
    q = apply_axial_rope(rms_norm(q, q_norm), cos, sin) * (HEAD_DIM ** -0.5)
    k = apply_axial_rope(rms_norm(k, k_norm), cos, sin)
    qb = q.reshape(b, s // Q_BLOCK, Q_BLOCK, GQA_KV_HEADS, GQA_GROUP, HEAD_DIM)

    def block(q_blk):
        sc = jnp.einsum('bqkgd,bskd->bkgqs', q_blk, k, preferred_element_type=jnp.float32)
        p = jax.nn.softmax(sc, axis=-1).astype(v.dtype)
        return jnp.einsum('bkgqs,bskd->bqkgd', p, v)

    out = lax.map(block, jnp.moveaxis(qb, 1, 0))
    out = jnp.moveaxis(out, 0, 1).reshape(b, s, nq)
    return out @ w_o


def conv_glu_ffn(x, w_up, conv_w, conv_b, w_down):
    h = dwconv_centered(x @ w_up, conv_w) + conv_b
    g, u = jnp.split(h, 2, axis=-1)
    return (jax.nn.silu(g) * u) @ w_down


def setup_inputs(seed: int = 0) -> dict:
    key = jax.random.key(seed)
    ks = iter(jax.random.split(key, 32))
    n_a, n_b, n_c = (len(range(m, DEPTH, N_MIXERS)) for m in range(N_MIXERS))

    def w(shape, fan_in):
        return jax.random.normal(next(ks), shape, jnp.float32) * (fan_in ** -0.5)

    def gain(shape):
        return 1.0 + 0.02 * jax.random.normal(next(ks), shape, jnp.float32)

    gqa_cols = (GQA_Q_HEADS + 2 * GQA_KV_HEADS) * HEAD_DIM
    return {
        "x": jax.random.normal(next(ks), (BATCH, SEQ, D_MODEL), jnp.float32),
        "mix_norm": gain((DEPTH, D_MODEL)),
        "ffn_norm": gain((DEPTH, D_MODEL)),
        "final_norm": gain((D_MODEL,)),
        "na_w_qkv": w((n_a, D_MODEL, 3 * NA_HEADS * HEAD_DIM), D_MODEL),
        "na_rpb": 0.1 * jax.random.normal(next(ks), (n_a, NA_HEADS, 2 * NA_WIN_R - 1, 2 * NA_WIN_C - 1), jnp.float32),
        "na_w_o": w((n_a, NA_HEADS * HEAD_DIM, D_MODEL), NA_HEADS * HEAD_DIM),
        "sc_w_in": w((n_b, D_MODEL, 3 * D_MODEL), D_MODEL),
        "sc_conv_w": w((n_b, SC_WIDTH, D_MODEL), SC_WIDTH),
        "sc_w_out": w((n_b, D_MODEL, D_MODEL), D_MODEL),
        "gqa_w_qkv": w((n_c, D_MODEL, gqa_cols), D_MODEL),
        "gqa_q_norm": gain((n_c, HEAD_DIM)),
        "gqa_k_norm": gain((n_c, HEAD_DIM)),
        "gqa_w_o": w((n_c, GQA_Q_HEADS * HEAD_DIM, D_MODEL), GQA_Q_HEADS * HEAD_DIM),
        "ffn_w_up": w((DEPTH, D_MODEL, 2 * D_FF), D_MODEL),
        "ffn_conv_w": w((DEPTH, FFN_CONV_WIDTH, 2 * D_FF), FFN_CONV_WIDTH),
        "ffn_conv_b": 0.01 * jax.random.normal(next(ks), (DEPTH, 2 * D_FF), jnp.float32),
        "ffn_w_down": w((DEPTH, D_FF, D_MODEL), D_FF),
    }


def reference(x, mix_norm, ffn_norm, final_norm, na_w_qkv, na_rpb, na_w_o,
              sc_w_in, sc_conv_w, sc_w_out, gqa_w_qkv, gqa_q_norm, gqa_k_norm,
              gqa_w_o, ffn_w_up, ffn_conv_w, ffn_conv_b, ffn_w_down):
    h = x
    for i in range(DEPTH):
        m, j = i % N_MIXERS, i // N_MIXERS
        a = rms_norm(h, mix_norm[i])
        if m == 0:
            mixed = neighborhood_attention(a, na_w_qkv[j], na_rpb[j], na_w_o[j])
        elif m == 1:
            mixed = short_conv_mixer(a, sc_w_in[j], sc_conv_w[j], sc_w_out[j])
        else:
            mixed = gqa_axial_attention(a, gqa_w_qkv[j], gqa_q_norm[j], gqa_k_norm[j], gqa_w_o[j])
        h = h + mixed
        h = h + conv_glu_ffn(rms_norm(h, ffn_norm[i]), ffn_w_up[i], ffn_conv_w[i],
                             ffn_conv_b[i], ffn_w_down[i])
    return rms_norm(h, final_norm)
```

```cpp
#include <hip/hip_runtime.h>
#include <hip/hip_cooperative_groups.h>
#include <cstdio>
#include <cstdint>
namespace cg = cooperative_groups;

#define LAS __attribute__((address_space(3)))
typedef unsigned short bf16_t;
typedef short bf16x8 __attribute__((ext_vector_type(8)));
typedef short s16x4 __attribute__((ext_vector_type(4)));
typedef float f32x4 __attribute__((ext_vector_type(4)));
typedef float f32x2 __attribute__((ext_vector_type(2)));
typedef float f32x16 __attribute__((ext_vector_type(16)));
typedef unsigned u32x4 __attribute__((ext_vector_type(4)));
typedef unsigned u32x2 __attribute__((ext_vector_type(2)));

constexpr int DM = 2048, NB = 8, SEQ = 2048, MT = NB * SEQ  , DEPTH = 4, HD = 128;
constexpr int GRID_W = 64, GRID_R = SEQ / GRID_W  ;
constexpr int NA_N = 3 * DM  , GQ_N = 3072, DFF = 5632, UP_N = 2 * DFF  ;
constexpr float EPS = 1e-6f;
constexpr int RTAB_OFF = 132096;

constexpr size_t SZ_W6144 = (size_t)6144 * 2048 * 2, SZ_W2048 = (size_t)2048 * 2048 * 2, SZ_W3072 = (size_t)3072 * 2048 * 2;
constexpr size_t SZ_WUP = (size_t)UP_N * 2048 * 2, SZ_WDN = (size_t)2048 * DFF * 2;
constexpr size_t WS_NAQKV = 0;
constexpr size_t WS_NAO = WS_NAQKV + 2 * SZ_W6144;
constexpr size_t WS_SCIN = WS_NAO + 2 * SZ_W2048;
constexpr size_t WS_SCOUT = WS_SCIN + SZ_W6144;
constexpr size_t WS_GQKV = WS_SCOUT + SZ_W2048;
constexpr size_t WS_GO = WS_GQKV + SZ_W3072;
constexpr size_t WS_UP = WS_GO + SZ_W2048;
constexpr size_t WS_DN = WS_UP + 4 * SZ_WUP;
constexpr size_t WS_XN = WS_DN + 4 * SZ_WDN;
constexpr size_t WS_BIG = WS_XN + (size_t)MT * DM * 2;
constexpr size_t WS_ACT = WS_BIG + (size_t)MT * UP_N * 2;
constexpr size_t WS_XH = WS_ACT + (size_t)MT * DFF * 2;
constexpr size_t WS_CTL = WS_XH + (size_t)MT * DM * 2;
constexpr size_t CTL_BYTES = 16384;
constexpr size_t WS_RAW = WS_CTL + CTL_BYTES;
constexpr size_t WS_SLOT = WS_RAW + (size_t)(MT / 64) * 4 * UP_N * 2;
constexpr size_t WS_RSTD = WS_SLOT + (size_t)9 * 32 * MT * 4;
constexpr size_t WS_END = WS_RSTD + (size_t)9 * MT * 4;

__device__ __forceinline__ unsigned cvt_pk_bf16(float lo, float hi) { unsigned r; asm volatile("v_cvt_pk_bf16_f32 %0, %1, %2" : "=v"(r) : "v"(lo), "v"(hi)); return r; }
__device__ __forceinline__ float bf_lo(unsigned w) { return __uint_as_float(w << 16); }
__device__ __forceinline__ float bf_hi(unsigned w) { return __uint_as_float(w & 0xffff0000u); }
template <int M> __device__ __forceinline__ float shx(float v) { return __int_as_float(__builtin_amdgcn_ds_swizzle(__float_as_int(v), (M << 10) | 0x1f)); }
template <int M> __device__ __forceinline__ unsigned shxu(unsigned v) { return (unsigned)__builtin_amdgcn_ds_swizzle((int)v, (M << 10) | 0x1f); }
__device__ __forceinline__ float add_x32(float v) { auto rr = __builtin_amdgcn_permlane32_swap(__float_as_uint(v), __float_as_uint(v), false, false); return __uint_as_float(rr[0]) + __uint_as_float(rr[1]); }
__device__ __forceinline__ float wave_sum(float v) {
    v += shx<1>(v); v += shx<2>(v); v += shx<4>(v); v += shx<8>(v); v += shx<16>(v);
    return add_x32(v);
}

__device__ __forceinline__ int tid_fresh(int wave_s) { int t = wave_s * 64 + (int)__builtin_amdgcn_mbcnt_hi(~0u, __builtin_amdgcn_mbcnt_lo(~0u, 0u)); asm volatile("" : "+v"(t)); return t; }

namespace pg8 {
constexpr int BM = 256, BK = 64, HALF = 128, HTB = HALF * BK * 2, STAGE_BYTES = 8 * HTB, NXCD = 8, WGM = 8;
__host__ __device__ __forceinline__ int lds_byte(int r, int c) { const int st = (r >> 4) * 2 + (c >> 5), rr = r & 15, cc = c & 31, ob = rr * 64 + cc * 2; return st * 1024 + (ob ^ (((ob >> 9) & 1) << 5)); }
__host__ __device__ __forceinline__ void stage_rc(int b, int& R, int& C) { const int st = b / 1024, sb = b % 1024, swz = sb ^ (((sb >> 9) & 1) << 5); R = (st >> 1) * 16 + swz / 64; C = (st & 1) * 32 + (swz % 64) / 2; }
__host__ __device__ __forceinline__ int perm32(int rho) { const int n = rho >> 4, i = rho & 15; return 8 * (i >> 2) + 4 * n + (i & 3); }
struct Unit { int pm, pn; };
struct Gemm { const bf16_t* A; const bf16_t* Bt; int M, N, K; size_t b_unit, b_half; };
struct StaticOrder {
    int nloc, X, R;
    __host__ __device__ void init(int N, int X_, int R_) { nloc = 8 * (N / BM); X = X_; R = R_; }
    __host__ __device__ bool next(int i, Unit& u) const {
        const int id = i * 32 + R; if (id >= nloc) return false;
        u.pm = 8 * X + (id & 7); u.pn = id >> 3; return true;
    }
};
struct EpiBf16 {
    static constexpr bool PERM = true, RSTD = true;
    bf16_t* O; int ldc; const float* rstd;
    __device__ __forceinline__ void operator()(f32x4 (&acc)[2][2][4][2], const Unit& u, int wr, int wc, int fr, int fq, const LAS float* rtab) const {
        const int row0 = u.pm * BM + wr * 64 + fr, col0 = u.pn * BM + wc * 32 + 8 * fq;
#pragma unroll
        for (int ai = 0; ai < 2; ++ai)
#pragma unroll
            for (int m = 0; m < 4; ++m) { bf16_t* rowp = O + (size_t)(row0 + ai * HALF + m * 16) * ldc + col0; const float r = rtab[ai * HALF + wr * 64 + m * 16 + fr];
#pragma unroll
                for (int bj = 0; bj < 2; ++bj) { const f32x4 v0 = acc[ai][bj][m][0] * r, v1 = acc[ai][bj][m][1] * r;
                    u32x4 w; w.x = cvt_pk_bf16(v0[0], v0[1]); w.y = cvt_pk_bf16(v0[2], v0[3]); w.z = cvt_pk_bf16(v1[0], v1[1]); w.w = cvt_pk_bf16(v1[2], v1[3]);
                    *(u32x4*)(rowp + bj * HALF) = w; } }
    }
};
struct EpiRes {
    static constexpr bool PERM = true, RSTD = false;
    bf16_t* h; int ldc; float* slot; const float* rstd;
    __device__ __forceinline__ void operator()(f32x4 (&acc)[2][2][4][2], const Unit& u, int wr, int wc, int fr, int fq, const LAS float*) const {
        const int row0 = u.pm * BM + wr * 64 + fr, col0 = u.pn * BM + wc * 32 + 8 * fq;
        float ssq[2][4];
#pragma unroll
        for (int ai = 0; ai < 2; ++ai) {
            u32x4 bs[4][2];
#pragma unroll
            for (int m = 0; m < 4; ++m)
#pragma unroll
                for (int bj = 0; bj < 2; ++bj) bs[m][bj] = *(const u32x4*)(h + (size_t)(row0 + ai * HALF + m * 16) * ldc + col0 + bj * HALF);
#pragma unroll
            for (int m = 0; m < 4; ++m) { float sq = 0.f;
#pragma unroll
                for (int bj = 0; bj < 2; ++bj) { const u32x4 b = bs[m][bj]; const f32x4 a0 = acc[ai][bj][m][0], a1 = acc[ai][bj][m][1];
                    const float v0 = bf_lo(b.x) + a0[0], v1 = bf_hi(b.x) + a0[1], v2 = bf_lo(b.y) + a0[2], v3 = bf_hi(b.y) + a0[3];
                    const float v4 = bf_lo(b.z) + a1[0], v5 = bf_hi(b.z) + a1[1], v6 = bf_lo(b.w) + a1[2], v7 = bf_hi(b.w) + a1[3];
                    u32x4 w; w.x = cvt_pk_bf16(v0, v1); w.y = cvt_pk_bf16(v2, v3); w.z = cvt_pk_bf16(v4, v5); w.w = cvt_pk_bf16(v6, v7);
                    *(u32x4*)(h + (size_t)(row0 + ai * HALF + m * 16) * ldc + col0 + bj * HALF) = w;
                    sq += (v0 * v0 + v1 * v1) + (v2 * v2 + v3 * v3) + (v4 * v4 + v5 * v5) + (v6 * v6 + v7 * v7); }
                sq += shx<16>(sq); sq = add_x32(sq); ssq[ai][m] = sq; }
            asm volatile("" ::: "memory");
        }
#pragma unroll
        for (int k = 0; k < 2; ++k) { const float v = fq == 0 ? ssq[k][0] : fq == 1 ? ssq[k][1] : fq == 2 ? ssq[k][2] : ssq[k][3];
            slot[(size_t)(u.pn * 4 + wc) * MT + row0 + k * HALF + fq * 16] = v; }
    }
};

template <int CTRL> __device__ __forceinline__ float dppz(float v) { return __int_as_float(__builtin_amdgcn_update_dpp(0, __float_as_int(v), CTRL, 0xf, 0xf, true)); }
struct EpiGlu {
    static constexpr bool PERM = true, RSTD = true;
    bf16_t* act; bf16_t* raw; const float* cw; const float* cb; const float* rstd;
    __device__ __forceinline__ void operator()(f32x4 (&acc)[2][2][4][2], const Unit& u, int wr, int wc, int fr, int fq, const LAS float* rtab) const {
        const int c0 = u.pn * 128 + wc * 32 + 8 * fq;
#pragma unroll
        for (int ai = 0; ai < 2; ++ai)
#pragma unroll
            for (int m = 0; m < 4; ++m) { const float r = rtab[ai * HALF + wr * 64 + m * 16 + fr];
#pragma unroll
                for (int bj = 0; bj < 2; ++bj)
#pragma unroll
                    for (int n = 0; n < 2; ++n) acc[ai][bj][m][n] = acc[ai][bj][m][n] * r; }
#pragma unroll
        for (int ai = 0; ai < 2; ++ai) {
            const int blk = (u.pm * BM + ai * HALF + wr * 64) >> 6;
            if (fr < 2) { bf16_t* rp = raw + ((size_t)blk * 4 + fr) * UP_N + c0;
                const f32x4 g0 = acc[ai][0][0][0], g1 = acc[ai][0][0][1], u0 = acc[ai][1][0][0], u1 = acc[ai][1][0][1];
                u32x4 w; w.x = cvt_pk_bf16(g0[0], g0[1]); w.y = cvt_pk_bf16(g0[2], g0[3]); w.z = cvt_pk_bf16(g1[0], g1[1]); w.w = cvt_pk_bf16(g1[2], g1[3]); *(u32x4*)rp = w;
                w.x = cvt_pk_bf16(u0[0], u0[1]); w.y = cvt_pk_bf16(u0[2], u0[3]); w.z = cvt_pk_bf16(u1[0], u1[1]); w.w = cvt_pk_bf16(u1[2], u1[3]); *(u32x4*)(rp + DFF) = w; }
            if (fr >= 14) { bf16_t* rp = raw + ((size_t)blk * 4 + (fr - 12)) * UP_N + c0;
                const f32x4 g0 = acc[ai][0][3][0], g1 = acc[ai][0][3][1], u0 = acc[ai][1][3][0], u1 = acc[ai][1][3][1];
                u32x4 w; w.x = cvt_pk_bf16(g0[0], g0[1]); w.y = cvt_pk_bf16(g0[2], g0[3]); w.z = cvt_pk_bf16(g1[0], g1[1]); w.w = cvt_pk_bf16(g1[2], g1[3]); *(u32x4*)rp = w;
                w.x = cvt_pk_bf16(u0[0], u0[1]); w.y = cvt_pk_bf16(u0[2], u0[3]); w.z = cvt_pk_bf16(u1[0], u1[1]); w.w = cvt_pk_bf16(u1[2], u1[3]); *(u32x4*)(rp + DFF) = w; }
        }
        u32x2 ypk[2][4];
#pragma unroll
        for (int n = 0; n < 2; ++n) {
            const int cn = c0 + 4 * n;
            const f32x4 wg0 = *(const f32x4*)(cw + cn), wg1 = *(const f32x4*)(cw + UP_N + cn), wg2 = *(const f32x4*)(cw + 2 * UP_N + cn), bg = *(const f32x4*)(cb + cn);
            const f32x4 wu0 = *(const f32x4*)(cw + DFF + cn), wu1 = *(const f32x4*)(cw + UP_N + DFF + cn), wu2 = *(const f32x4*)(cw + 2 * UP_N + DFF + cn), bu = *(const f32x4*)(cb + DFF + cn);
#pragma unroll
            for (int ai = 0; ai < 2; ++ai) {
                const int r64 = u.pm * BM + ai * HALF + wr * 64;
#pragma unroll
                for (int m = 0; m < 4; ++m) {
                    float y[4];
#pragma unroll
                    for (int jj = 0; jj < 4; ++jj) {
                        const float gc = acc[ai][0][m][n][jj], uc = acc[ai][1][m][n][jj];
                        const float gb = m > 0 ? acc[ai][0][m - 1][n][jj] : 0.f, ga = m < 3 ? acc[ai][0][m + 1][n][jj] : 0.f;
                        const float ub = m > 0 ? acc[ai][1][m - 1][n][jj] : 0.f, ua = m < 3 ? acc[ai][1][m + 1][n][jj] : 0.f;
                        const float gp = dppz<0x111>(gc) + dppz<0x10F>(gb), gn = dppz<0x101>(gc) + dppz<0x11F>(ga);
                        const float up = dppz<0x111>(uc) + dppz<0x10F>(ub), un = dppz<0x101>(uc) + dppz<0x11F>(ua);
                        const float hg = wg0[jj] * gp + wg1[jj] * gc + wg2[jj] * gn + bg[jj];
                        const float hu = wu0[jj] * up + wu1[jj] * uc + wu2[jj] * un + bu[jj];
                        const float sg = __builtin_amdgcn_rcpf(1.f + __builtin_amdgcn_exp2f(-1.4426950408889634f * hg));
                        y[jj] = hg * sg * hu; }
                    u32x2 pk; pk.x = cvt_pk_bf16(y[0], y[1]); pk.y = cvt_pk_bf16(y[2], y[3]);
                    if (n == 0) ypk[ai][m] = pk;
                    else {
                        const bool deferred = (m == 0 && fr == 0) || (m == 3 && fr == 15);
                        if (!deferred) { u32x4 w; w.x = ypk[ai][m].x; w.y = ypk[ai][m].y; w.z = pk.x; w.w = pk.y; *(u32x4*)(act + (size_t)(r64 + m * 16 + fr) * DFF + c0) = w; } }
                }
            }
        }
    }
};

template <class Epi, int STAG = 0>
__device__ __forceinline__ void gemm_phase(LAS unsigned char* lds, const Gemm g, const StaticOrder& S, const Epi& E, int wave_s) {
    const int tid = tid_fresh(wave_s), wid = __builtin_amdgcn_readfirstlane(tid >> 6), lane = tid & 63, wr = wid >> 2, wc = wid & 3, fr = lane & 15, fq = lane >> 4;
    const int K = g.K, nt = K / BK;
    unsigned voffA[2], voffB[2];
#pragma unroll
    for (int i = 0; i < 2; ++i) { int R, C; stage_rc(tid * 16 + i * 8192, R, C); const int Rb = Epi::PERM ? ((R & ~31) + perm32(R & 31)) : R;
        voffA[i] = (unsigned)(R * K + C) * 2u; voffB[i] = (unsigned)(Rb * K + C) * 2u; }
    const size_t kstep = (size_t)(BK * 2);
    const size_t hstep = (size_t)HALF * K * 2;
    const size_t tstep = 2 * hstep;
    const size_t bunit = g.b_unit, bh = g.b_half;
    const unsigned ldsw = (unsigned)wid * 1024u;
    const int aoff = lds_byte(wr * 64 + fr, fq * 8), boff = lds_byte(wc * 32 + fr, fq * 8);
#define PG8_SA(b, h) (((b) * 2 + (h)) * HTB)
#define PG8_SB(b, h) ((4 + (b) * 2 + (h)) * HTB)
#define PG8_STAGE(bufoff, gbase, voff) do { _Pragma("unroll") for (int _i = 0; _i < 2; ++_i) \
        __builtin_amdgcn_global_load_lds((const unsigned*)((const char*)(gbase) + (voff)[_i]), (LAS unsigned*)(lds + (bufoff) + ldsw + _i * 8192), 16, 0, 0); } while (0)
#define PG8_LDA(dst, b, h) do { _Pragma("unroll") for (int m = 0; m < 4; ++m) _Pragma("unroll") for (int k = 0; k < 2; ++k) dst[m][k] = *(const LAS bf16x8*)(lds + PG8_SA(b, h) + aoff + m * 2048 + k * 1024); } while (0)
#define PG8_LDB(dst, b, h) do { _Pragma("unroll") for (int n = 0; n < 2; ++n) _Pragma("unroll") for (int k = 0; k < 2; ++k) dst[n][k] = *(const LAS bf16x8*)(lds + PG8_SB(b, h) + boff + n * 2048 + k * 1024); } while (0)
#define PG8_MMA(ai, bj, At, Bt) do { __builtin_amdgcn_s_setprio(1); _Pragma("unroll") for (int m = 0; m < 4; ++m) _Pragma("unroll") for (int n = 0; n < 2; ++n) _Pragma("unroll") for (int k = 0; k < 2; ++k) \
        acc[ai][bj][m][n] = __builtin_amdgcn_mfma_f32_16x16x32_bf16(Bt[n][k], At[m][k], acc[ai][bj][m][n], 0, 0, 0); __builtin_amdgcn_s_setprio(0); } while (0)
#define PG8_WAIT_V(n) asm volatile("s_waitcnt vmcnt(" #n ")" ::: "memory")
#define PG8_WAIT_L(n) asm volatile("s_waitcnt lgkmcnt(" #n ")" ::: "memory")
#define PG8_BAR __builtin_amdgcn_s_barrier()
#define PG8_SCHED __builtin_amdgcn_sched_barrier(0)
    Unit cur, nxt; int ui = 0;
    if (!S.next(0, cur)) return;
    if constexpr (Epi::RSTD) {
        LAS float* tab = (LAS float*)(lds + RTAB_OFF);
        for (int idx = tid; idx < 11 * 256; idx += 512) { Unit uu; if (S.next(idx >> 8, uu)) tab[idx] = E.rstd[uu.pm * BM + (idx & 255)]; }
        asm volatile("s_waitcnt vmcnt(0) lgkmcnt(0)" ::: "memory"); __builtin_amdgcn_s_barrier(); asm volatile("" ::: "memory");
    }
    f32x4 acc[2][2][4][2];
#pragma unroll
    for (int a = 0; a < 2; ++a)
#pragma unroll
        for (int b = 0; b < 2; ++b)
#pragma unroll
            for (int m = 0; m < 4; ++m)
#pragma unroll
                for (int n = 0; n < 2; ++n) acc[a][b][m][n] = (f32x4){0.f, 0.f, 0.f, 0.f};
    bf16x8 At[4][2], B0[2][2], B1[2][2];
    const char* cA = (const char*)g.A + (size_t)cur.pm * tstep; const char* cB = (const char*)g.Bt + (size_t)cur.pn * bunit;
    PG8_STAGE(PG8_SB(0, 0), cB, voffB); PG8_STAGE(PG8_SB(0, 1), cB + bh, voffB); PG8_STAGE(PG8_SA(0, 0), cA, voffA); PG8_STAGE(PG8_SA(0, 1), cA + hstep, voffA);
    if (wr == 1) PG8_BAR;
    PG8_WAIT_V(2); PG8_BAR;
    PG8_STAGE(PG8_SB(1, 0), cB + kstep, voffB); PG8_STAGE(PG8_SA(1, 0), cA + kstep, voffA); PG8_STAGE(PG8_SB(1, 1), cB + bh + kstep, voffB);
    PG8_WAIT_V(6); PG8_BAR;
    for (;;) {
        const bool has_next = S.next(ui + 1, nxt);
        const char* nA = has_next ? (const char*)g.A + (size_t)nxt.pm * tstep : cA; const char* nB = has_next ? (const char*)g.Bt + (size_t)nxt.pn * bunit : cB;
        for (int t = 0; t < nt; t += 2) {
            const bool last = (t == nt - 2);
            const char* a1 = cA + (size_t)(t + 1) * kstep;
            const char* a2 = last ? nA : cA + (size_t)(t + 2) * kstep; const char* b2 = last ? nB : cB + (size_t)(t + 2) * kstep;
            const char* a3 = a2 + kstep; const char* b3 = b2 + kstep;
            PG8_LDB(B0, 0, 0); PG8_LDB(B1, 0, 1); PG8_SCHED; PG8_LDA(At, 0, 0); PG8_STAGE(PG8_SA(1, 1), a1 + hstep, voffA);
            PG8_WAIT_V(8); PG8_WAIT_L(0); PG8_BAR; PG8_MMA(0, 0, At, B0); PG8_MMA(0, 1, At, B1); PG8_BAR; PG8_SCHED;
            PG8_LDA(At, 0, 1); PG8_STAGE(PG8_SB(0, 0), b2, voffB); PG8_STAGE(PG8_SB(0, 1), b2 + bh, voffB); PG8_STAGE(PG8_SA(0, 0), a2, voffA);
            PG8_WAIT_V(8); PG8_WAIT_L(0); PG8_BAR; PG8_MMA(1, 0, At, B0); PG8_MMA(1, 1, At, B1); PG8_BAR; PG8_SCHED;
            PG8_LDB(B0, 1, 0); PG8_LDB(B1, 1, 1); PG8_SCHED; PG8_LDA(At, 1, 0); PG8_STAGE(PG8_SA(0, 1), a2 + hstep, voffA);
            PG8_WAIT_V(8); PG8_WAIT_L(0); PG8_BAR; PG8_MMA(0, 0, At, B0); PG8_MMA(0, 1, At, B1); PG8_BAR; PG8_SCHED;
            PG8_LDA(At, 1, 1); PG8_STAGE(PG8_SB(1, 0), b3, voffB); PG8_STAGE(PG8_SB(1, 1), b3 + bh, voffB); PG8_STAGE(PG8_SA(1, 0), a3, voffA);
            PG8_WAIT_V(8); PG8_WAIT_L(0); PG8_BAR; PG8_MMA(1, 0, At, B0); PG8_MMA(1, 1, At, B1); PG8_BAR; PG8_SCHED;
        }
        if (wr == 0) PG8_BAR;
        E(acc, cur, wr, wc, fr, fq, (const LAS float*)(lds + RTAB_OFF) + ui * 256);
        if (!has_next) break;
#pragma unroll
        for (int a = 0; a < 2; ++a)
#pragma unroll
            for (int b = 0; b < 2; ++b)
#pragma unroll
                for (int m = 0; m < 4; ++m)
#pragma unroll
                    for (int n = 0; n < 2; ++n) acc[a][b][m][n] = (f32x4){0.f, 0.f, 0.f, 0.f};
        cur = nxt; cA = nA; cB = nB; ++ui;
        if (wr == 1) PG8_BAR;
    }
    PG8_WAIT_V(0);
    PG8_BAR;
#undef PG8_SA
#undef PG8_SB
#undef PG8_STAGE
#undef PG8_LDA
#undef PG8_LDB
#undef PG8_MMA
#undef PG8_WAIT_V
#undef PG8_WAIT_L
#undef PG8_BAR
#undef PG8_SCHED
}
}

namespace att {
constexpr int D = 128, NW = 8, QBLK = 32, KVBLK = 64;
constexpr float SCALE = 0.088388347648318440f;
constexpr float THR = 8.f;
constexpr size_t SHM_V = KVBLK * D * 2, SHM_K = KVBLK * D * 2, SHM_ATTN = 2 * SHM_V + 2 * SHM_K + NW * 64 * 4;
constexpr size_t SHM_OST = 77312;
constexpr size_t SHM_BIAS = 69632;
#define KSWZ(row, colB) ((row) * 256 + ((colB) ^ (((row) & 7) << 4)))
#define SBAR() __builtin_amdgcn_sched_barrier(0)
__device__ __forceinline__ int crow(int r, int hi) { return (r & 3) + 8 * (r >> 2) + 4 * hi; }
__device__ __forceinline__ unsigned cvtpk(float lo, float hi) { unsigned r; asm volatile("v_cvt_pk_bf16_f32 %0, %1, %2" : "=v"(r) : "v"(lo), "v"(hi)); return r; }

__device__ __forceinline__ void partialSM(f32x16& p0, f32x16& p1, float& m_reg, float& mn, float& alpha) {
  constexpr float C = SCALE * 1.4426950408889634f;
  float pmax = p0[0];
#pragma unroll
  for (int r = 1; r < 16; ++r) pmax = fmaxf(pmax, p0[r]);
#pragma unroll
  for (int r = 0; r < 16; ++r) pmax = fmaxf(pmax, p1[r]);
  { auto rr = __builtin_amdgcn_permlane32_swap(__float_as_uint(pmax), __float_as_uint(pmax), false, false);
    pmax = fmaxf(__uint_as_float(rr[0]), __uint_as_float(rr[1])); }
  if (__builtin_expect(__all(pmax - m_reg <= THR / SCALE), 1)) { mn = m_reg; alpha = 1.f; }
  else { mn = fmaxf(m_reg, pmax); alpha = __builtin_amdgcn_exp2f((m_reg - mn) * C); m_reg = mn; }
  float mnC = -mn * C;
#pragma unroll
  for (int r = 0; r < 16; ++r) p0[r] = fmaf(p0[r], C, mnC);
#pragma unroll
  for (int r = 0; r < 16; ++r) p1[r] = fmaf(p1[r], C, mnC);
#pragma unroll
  for (int r = 0; r < 16; ++r) p0[r] = __builtin_amdgcn_exp2f(p0[r]);
}
__device__ __forceinline__ void finishSM(f32x16& p0, f32x16& p1, float alpha, float& l_reg, bf16x8& pa0, bf16x8& pa1, bf16x8& pa2, bf16x8& pa3) {
#pragma unroll
  for (int r = 0; r < 16; ++r) p1[r] = __builtin_amdgcn_exp2f(p1[r]);
  float ps = 0;
#pragma unroll
  for (int r = 0; r < 16; ++r) ps += p0[r];
#pragma unroll
  for (int r = 0; r < 16; ++r) ps += p1[r];
  { auto rr = __builtin_amdgcn_permlane32_swap(__float_as_uint(ps), __float_as_uint(ps), false, false);
    ps = __uint_as_float(rr[0]) + __uint_as_float(rr[1]); }
  l_reg = l_reg * alpha + ps;
#define PK4(P, BASE, OUT) do { unsigned a0 = cvtpk(P[BASE + 0], P[BASE + 1]), a1 = cvtpk(P[BASE + 2], P[BASE + 3]);   \
    unsigned b0 = cvtpk(P[BASE + 4], P[BASE + 5]), b1 = cvtpk(P[BASE + 6], P[BASE + 7]);                              \
    auto r0 = __builtin_amdgcn_permlane32_swap(a0, b0, false, false); auto r1 = __builtin_amdgcn_permlane32_swap(a1, b1, false, false); \
    u32x4 w = {r0[0], r1[0], r0[1], r1[1]}; OUT = *reinterpret_cast<bf16x8*>(&w); } while (0)
  PK4(p0, 0, pa0); PK4(p0, 8, pa1); PK4(p1, 0, pa2); PK4(p1, 8, pa3);
#undef PK4
}
__device__ __forceinline__ void qkt(f32x16& p0, f32x16& p1, const bf16_t* Ks, const bf16x8* qr, int r32, int hi) {
  p0 = f32x16{}; p1 = f32x16{};
#pragma unroll
  for (int d0 = 0; d0 < 8; ++d0) { int cb = (d0 * 16 + hi * 8) * 2;
    bf16x8 b0 = *reinterpret_cast<const bf16x8*>((const char*)Ks + KSWZ(r32, cb));
    bf16x8 b1 = *reinterpret_cast<const bf16x8*>((const char*)Ks + KSWZ(32 + r32, cb));
    p0 = __builtin_amdgcn_mfma_f32_32x32x16_bf16(b0, qr[d0], p0, 0, 0, 0);
    p1 = __builtin_amdgcn_mfma_f32_32x32x16_bf16(b1, qr[d0], p1, 0, 0, 0); }
}
__device__ __forceinline__ int v_st(int k, int c) { const int kk = (k & ~0xC) | ((k & 4) << 1) | ((k & 8) >> 1); return ((kk >> 3) * 4 + (c >> 5)) * 512 + ((kk & 7) * 32 + (c & 31)) * 2; }
__device__ __forceinline__ int v_rd_base(int lane) { return ((lane & 3) << 3) | (((lane >> 2) & 3) << 6) | (((lane >> 4) & 1) << 5) | (((lane >> 5) & 1) << 8); }
constexpr int v_rd_off(int d0, int ks, int half) { return d0 * 512 + ks * 4096 + half * 2048; }
template <int OFF> __device__ __forceinline__ s16x4 tr_read(int vb) {
  s16x4 r; asm volatile("ds_read_b64_tr_b16 %0, %1 offset:%2" : "=&v"(r) : "v"(vb), "i"(OFF) : "memory"); return r;
}
template <int D0> __device__ __forceinline__ void pv_one(f32x16& od, int vb, bf16x8 pa0, bf16x8 pa1, bf16x8 pa2, bf16x8 pa3) {
  const s16x4 l0 = tr_read<v_rd_off(D0, 0, 0)>(vb), h0 = tr_read<v_rd_off(D0, 0, 1)>(vb), l1 = tr_read<v_rd_off(D0, 1, 0)>(vb), h1 = tr_read<v_rd_off(D0, 1, 1)>(vb);
  const s16x4 l2 = tr_read<v_rd_off(D0, 2, 0)>(vb), h2 = tr_read<v_rd_off(D0, 2, 1)>(vb), l3 = tr_read<v_rd_off(D0, 3, 0)>(vb), h3 = tr_read<v_rd_off(D0, 3, 1)>(vb);
  asm volatile("s_waitcnt lgkmcnt(0)" ::: "memory"); SBAR();
#define PK(L, H) (bf16x8){L[0], L[1], L[2], L[3], H[0], H[1], H[2], H[3]}
  od = __builtin_amdgcn_mfma_f32_32x32x16_bf16(pa0, PK(l0, h0), od, 0, 0, 0);
  od = __builtin_amdgcn_mfma_f32_32x32x16_bf16(pa1, PK(l1, h1), od, 0, 0, 0);
  od = __builtin_amdgcn_mfma_f32_32x32x16_bf16(pa2, PK(l2, h2), od, 0, 0, 0);
  od = __builtin_amdgcn_mfma_f32_32x32x16_bf16(pa3, PK(l3, h3), od, 0, 0, 0);
#undef PK
}
__device__ __forceinline__ void pv_d0(f32x16* o, int vb, bf16x8 pa0, bf16x8 pa1, bf16x8 pa2, bf16x8 pa3) {
  pv_one<0>(o[0], vb, pa0, pa1, pa2, pa3); pv_one<1>(o[1], vb, pa0, pa1, pa2, pa3); pv_one<2>(o[2], vb, pa0, pa1, pa2, pa3); pv_one<3>(o[3], vb, pa0, pa1, pa2, pa3);
}
__device__ __forceinline__ void na_mask(f32x16& p0, f32x16& p1, int kr, int qr_, int rs, int qc, int cs, int hi, const float* bias) {
  const float NEG = -1e30f;
  if (kr < rs || kr >= rs + 8) {
#pragma unroll
    for (int i = 0; i < 16; ++i) { p0[i] = NEG; p1[i] = NEG; }
    return;
  }
  const float* bp = bias + (kr - qr_ + 7) * 128 + (4 * hi - qc + 63);
  const int e = 4 * hi - cs;
#pragma unroll
  for (int i = 0; i < 16; ++i) {
    const int ci = (i & 3) + 8 * (i >> 2);
    const float b0 = bp[ci], b1 = bp[ci + 32];
    p0[i] = ((unsigned)(ci + e) < 16u) ? p0[i] + b0 : NEG;
    p1[i] = ((unsigned)(ci + 32 + e) < 16u) ? p1[i] + b1 : NEG;
  }
}

template <bool NA, int LD, int LDO>
__device__ __forceinline__ void attn_body(const bf16_t* __restrict__ Qb, const bf16_t* __restrict__ Kh, const bf16_t* __restrict__ Vh,
                                          bf16_t* __restrict__ Ob, int NT, char* lds, int r0, int kr0, const float* bias, int wave_s) {
  const int tid = tid_fresh(wave_s), wid = __builtin_amdgcn_readfirstlane(tid >> 6), lane = tid & 63, r32 = lane & 31, hi = lane >> 5;
  bf16_t* V_lds = (bf16_t*)lds; bf16_t* K_lds = (bf16_t*)(lds + 2 * SHM_V);
  float* ws = (float*)(lds + 2 * SHM_V + 2 * SHM_K) + wid * 64; float* li_l = ws; float* al_l = ws + 32;
  float m_reg = NA ? -3e4f : -1e30f, l_reg = 0; f32x16 o[4] = {}; bf16x8 qr[8];
  const int qrow = r0 + (wid >> 1), rs = min(max(qrow - 4, 0), GRID_R - 8), qc = 32 * (wid & 1) + r32, cs = min(max(qc - 8, 0), GRID_W - 16);
  const bf16_t* Qw = Qb + (long)(wid * QBLK + r32) * LD + hi * 8;
#pragma unroll
  for (int d0 = 0; d0 < 8; ++d0) qr[d0] = *reinterpret_cast<const bf16x8*>(Qw + d0 * 16);
  const int sr = tid >> 4, sc = (tid & 15) * 8, vst0 = v_st(sr, sc), vst1 = v_st(32 + sr, sc);
  const int vb0 = (int)(uintptr_t)V_lds + v_rd_base(lane);
  constexpr int SD = NA ? 1 : 2;
  struct { bf16x8 vs0, vs1, ks0, ks1; } sr_[SD];
#define SLOAD(i, k0) do { sr_[i].vs0 = *reinterpret_cast<const bf16x8*>(&Vh[(long)((k0) + sr) * LD + sc]); sr_[i].vs1 = *reinterpret_cast<const bf16x8*>(&Vh[(long)((k0) + 32 + sr) * LD + sc]); \
    sr_[i].ks0 = *reinterpret_cast<const bf16x8*>(&Kh[(long)((k0) + sr) * LD + sc]); sr_[i].ks1 = *reinterpret_cast<const bf16x8*>(&Kh[(long)((k0) + 32 + sr) * LD + sc]); } while (0)
#define SWRITE(b, i) do { *(bf16x8*)((char*)V_lds + (b) * SHM_V + vst0) = sr_[i].vs0;          \
    *(bf16x8*)((char*)V_lds + (b) * SHM_V + vst1) = sr_[i].vs1; int kc = sc * 2;               \
    *(bf16x8*)((char*)K_lds + (b) * SHM_K + KSWZ(sr, kc)) = sr_[i].ks0;                       \
    *(bf16x8*)((char*)K_lds + (b) * SHM_K + KSWZ(32 + sr, kc)) = sr_[i].ks1; } while (0)
#define SWAIT() do { if constexpr (SD == 2) asm volatile("s_waitcnt vmcnt(4)" ::: "memory"); else asm volatile("s_waitcnt vmcnt(0)" ::: "memory"); } while (0)
#define RESC(a) do { if (__any((a) < 1.f)) { if (hi == 0) al_l[r32] = (a); asm volatile("s_waitcnt lgkmcnt(0)" ::: "memory"); \
    _Pragma("unroll") for (int d = 0; d < 4; ++d) _Pragma("unroll") for (int r = 0; r < 16; ++r) o[d][r] *= al_l[crow(r, hi)]; } } while (0)
#define NAM(P0, P1, j) do { if constexpr (NA) na_mask(P0, P1, kr0 + (j), qrow, rs, qc, cs, hi, bias); } while (0)
  f32x16 pA0, pA1, pB0, pB1; float mnA, mnB, alA, alB; bf16x8 pa0, pa1, pa2, pa3;
  constexpr int SE = 0, SO = SD - 1;
#define VALID(j) (!NA || (kr0 + (j) >= rs && kr0 + (j) < rs + 8))
  bool vA, vB;
  SLOAD(SE, 0); asm volatile("s_waitcnt vmcnt(0)" ::: "memory"); SWRITE(0, SE); __syncthreads();
  vA = VALID(0); alA = 1.f;
  if (vA) { qkt(pA0, pA1, K_lds, qr, r32, hi); NAM(pA0, pA1, 0); partialSM(pA0, pA1, m_reg, mnA, alA); }
  SLOAD(SO, KVBLK); if constexpr (SD == 2) { if (2 < NT) SLOAD(SE, 2 * KVBLK); }
  SWAIT(); SWRITE(1, SO); __syncthreads();
  for (int j = 1; j + 1 < NT; j += 2) {
    vB = VALID(j); alB = 1.f;
    SBAR(); if (vB) qkt(pB0, pB1, (bf16_t*)((char*)K_lds + SHM_K), qr, r32, hi);
    SLOAD(SO, (j + SD) * KVBLK); SBAR();
    if (vA) { finishSM(pA0, pA1, alA, l_reg, pa0, pa1, pa2, pa3); SBAR(); pv_d0(o, vb0, pa0, pa1, pa2, pa3); }
    if (vB) { NAM(pB0, pB1, j); partialSM(pB0, pB1, m_reg, mnB, alB); }
    __syncthreads(); SWAIT(); SWRITE(0, SE);
    RESC(alB); __syncthreads();
    vA = VALID(j + 1); alA = 1.f;
    SBAR(); if (vA) qkt(pA0, pA1, K_lds, qr, r32, hi);
    if (SD == 1 || j + 3 < NT) SLOAD(SE, (j + 1 + SD) * KVBLK); SBAR();
    if (vB) { finishSM(pB0, pB1, alB, l_reg, pa0, pa1, pa2, pa3); SBAR(); pv_d0(o, vb0 + (int)SHM_V, pa0, pa1, pa2, pa3); }
    if (vA) { NAM(pA0, pA1, j + 1); partialSM(pA0, pA1, m_reg, mnA, alA); }
    __syncthreads(); SWAIT(); SWRITE(1, SO);
    RESC(alA); __syncthreads();
  }
  vB = VALID(NT - 1); alB = 1.f;
  SBAR(); if (vB) qkt(pB0, pB1, (bf16_t*)((char*)K_lds + SHM_K), qr, r32, hi);
  if (vA) { finishSM(pA0, pA1, alA, l_reg, pa0, pa1, pa2, pa3); SBAR(); pv_d0(o, vb0, pa0, pa1, pa2, pa3); }
  if (vB) { NAM(pB0, pB1, NT - 1); partialSM(pB0, pB1, m_reg, mnB, alB); }
  __syncthreads(); RESC(alB);
  if (vB) { finishSM(pB0, pB1, alB, l_reg, pa0, pa1, pa2, pa3); SBAR();
    pv_d0(o, vb0 + (int)SHM_V, pa0, pa1, pa2, pa3); }
#undef VALID
  if (hi == 0) li_l[r32] = l_reg; asm volatile("s_waitcnt lgkmcnt(0)" ::: "memory");
  float rli[16];
#pragma unroll
  for (int r = 0; r < 16; ++r) rli[r] = __builtin_amdgcn_rcpf(li_l[crow(r, hi)]);
  bf16_t* Ow = Ob + (long)(wid * QBLK) * LDO;
  {
    bf16_t* stg = (bf16_t*)(lds + SHM_OST) + wid * 4096;
#pragma unroll
    for (int r = 0; r < 16; ++r) { const int orow = crow(r, hi);
#pragma unroll
      for (int d0 = 0; d0 < 4; ++d0) stg[orow * 128 + d0 * 32 + r32] = (bf16_t)(cvtpk(o[d0][r] * rli[r], 0.f) & 0xffffu); }
    asm volatile("s_waitcnt lgkmcnt(0)" ::: "memory");
#pragma unroll
    for (int i = 0; i < 8; ++i) { const int row = i * 4 + (lane >> 4), ch = lane & 15; const u32x4 v = *(const u32x4*)(stg + row * 128 + ch * 8); *(u32x4*)(Ow + (long)row * LDO + ch * 8) = v; }
  }
  __syncthreads();
#undef SLOAD
#undef SWRITE
#undef SWAIT
#undef RESC
#undef NAM
}
#undef SBAR
}

struct Params {
    const float* x; const float* mix_norm; const float* ffn_norm; const float* final_norm;
    const float* na_w_qkv; const float* na_rpb; const float* na_w_o;
    const float* sc_w_in; const float* sc_conv_w; const float* sc_w_out;
    const float* gqa_w_qkv; const float* gqa_q_norm; const float* gqa_k_norm; const float* gqa_w_o;
    const float* ffn_w_up; const float* ffn_conv_w; const float* ffn_conv_b; const float* ffn_w_down;
    float* out; unsigned char* ws;
};

constexpr int NTHREADS = 512, NWAVES = 8;
constexpr int CTLW_OFF = RTAB_OFF + 11 * 1024;
constexpr int LDS_BYTES = CTLW_OFF + 1024;

__device__ __forceinline__ void transpose_item(const float* __restrict__ W, const float* __restrict__ gain, int K, int N, bf16_t* __restrict__ WT, LAS float* scr, int item, int lane) {
    const int nblk = N / 32, kb = item / nblk, nb = item % nblk, k0 = 64 * kb, n0 = 32 * nb;
#pragma unroll 8
    for (int i = 0; i < 32; ++i) { const int kk = 2 * i + (lane >> 5); scr[kk * 33 + (lane & 31)] = W[(size_t)(k0 + kk) * N + n0 + (lane & 31)]; }
    asm volatile("s_waitcnt lgkmcnt(0)" ::: "memory");
    const int c = lane & 7;
    f32x4 g0 = {1.f, 1.f, 1.f, 1.f}, g1 = {1.f, 1.f, 1.f, 1.f};
    if (gain) { g0 = *(const f32x4*)(gain + k0 + 8 * c); g1 = *(const f32x4*)(gain + k0 + 8 * c + 4); }
#pragma unroll
    for (int j = 0; j < 4; ++j) { const int n = (lane >> 3) + 8 * j; const LAS float* s = scr + (8 * c) * 33 + n;
        u32x4 o; o.x = cvt_pk_bf16(s[0 * 33] * g0.x, s[1 * 33] * g0.y); o.y = cvt_pk_bf16(s[2 * 33] * g0.z, s[3 * 33] * g0.w); o.z = cvt_pk_bf16(s[4 * 33] * g1.x, s[5 * 33] * g1.y); o.w = cvt_pk_bf16(s[6 * 33] * g1.z, s[7 * 33] * g1.w);
        *(u32x4*)(WT + (size_t)(n0 + n) * K + k0 + 8 * c) = o; }
    asm volatile("s_waitcnt lgkmcnt(0)" ::: "memory");
}
__device__ __forceinline__ void convert_matrix(const float* W, const float* gain, int K, int N, bf16_t* WT, LAS float* scr, int gw, int ngw, int lane) {
    const int items = (K / 64) * (N / 32);
    for (int it = gw; it < items; it += ngw) transpose_item(W, gain, K, N, WT, scr, it, lane);
}
__device__ __forceinline__ void unpack8(const u32x4 w, float* f);
__device__ __forceinline__ void x_prep_rows(const float* X, bf16_t* XH, float* rstd, int gw, int ngw, int lane) {
    for (int m = gw; m < MT; m += ngw) {
        const f32x4* xr = (const f32x4*)(X + (size_t)m * DM) + lane;
        f32x4 v[8]; float s = 0.f;
#pragma unroll
        for (int j = 0; j < 8; ++j) { v[j] = xr[64 * j]; s += (v[j].x * v[j].x + v[j].y * v[j].y) + (v[j].z * v[j].z + v[j].w * v[j].w); }
        s = wave_sum(s);
        if (lane == 0) rstd[m] = rsqrtf(s * (1.f / DM) + EPS);
        u32x2* h8 = (u32x2*)(XH + (size_t)m * DM) + lane;
#pragma unroll
        for (int j = 0; j < 8; ++j) { u32x2 w; w.x = cvt_pk_bf16(v[j].x, v[j].y); w.y = cvt_pk_bf16(v[j].z, v[j].w); h8[64 * j] = w; }
    }
}
__device__ __forceinline__ void rstd_pass(const float* Pg, float* rstdg, int gtid, int gthreads, int tok0) {
    const float* P = Pg + tok0; float* rstd = rstdg + tok0;
    for (int r = gtid >> 3; r < SEQ; r += gthreads >> 3) {
        const int part = gtid & 7; float sq = 0.f;
#pragma unroll
        for (int i = 0; i < 4; ++i) sq += P[(size_t)(part * 4 + i) * MT + r];
        sq += shx<1>(sq); sq += shx<2>(sq); sq += shx<4>(sq);
        if (part == 0) rstd[r] = rsqrtf(sq * (1.f / DM) + EPS);
    }
}
__device__ __forceinline__ void rmsnorm_rows_f32(const bf16_t* Xg, const float* __restrict__ g, float* Og, int gw, int ngw, int lane, int tok0) {
    const bf16_t* X = Xg + (size_t)tok0 * DM; float* O = Og + (size_t)tok0 * DM;
    for (int m = gw; m < SEQ; m += ngw) {
        const u32x4* xr = (const u32x4*)(X + (size_t)m * DM) + lane;
        float v[4][8]; float s = 0.f;
#pragma unroll
        for (int j = 0; j < 4; ++j) { unpack8(xr[64 * j], v[j]);
#pragma unroll
            for (int e = 0; e < 8; ++e) s += v[j][e] * v[j][e]; }
        const float rstd = rsqrtf(wave_sum(s) * (1.f / DM) + EPS);
        float* o = O + (size_t)m * DM;
#pragma unroll
        for (int j = 0; j < 4; ++j) { const f32x4 g0 = *(const f32x4*)(g + 512 * j + 8 * lane), g1 = *(const f32x4*)(g + 512 * j + 8 * lane + 4);
            *(f32x4*)(o + 512 * j + 8 * lane) = (f32x4){v[j][0] * rstd * g0.x, v[j][1] * rstd * g0.y, v[j][2] * rstd * g0.z, v[j][3] * rstd * g0.w};
            *(f32x4*)(o + 512 * j + 8 * lane + 4) = (f32x4){v[j][4] * rstd * g1.x, v[j][5] * rstd * g1.y, v[j][6] * rstd * g1.z, v[j][7] * rstd * g1.w}; }
    }
}

__device__ __forceinline__ void unpack8(const u32x4 w, float* f) {
    f[0] = bf_lo(w.x); f[1] = bf_hi(w.x); f[2] = bf_lo(w.y); f[3] = bf_hi(w.y); f[4] = bf_lo(w.z); f[5] = bf_hi(w.z); f[6] = bf_lo(w.w); f[7] = bf_hi(w.w);
}
__device__ __forceinline__ u32x4 pack8(const float* f) {
    u32x4 w; w.x = cvt_pk_bf16(f[0], f[1]); w.y = cvt_pk_bf16(f[2], f[3]); w.z = cvt_pk_bf16(f[4], f[5]); w.w = cvt_pk_bf16(f[6], f[7]); return w;
}

__device__ __forceinline__ void sc_conv_phase(const bf16_t* U, const float* __restrict__ cw, bf16_t* Y, int gtid, int gthreads, int tok0) {
    constexpr int CH = 16, R = 8, NG = DM / 8, NITEM = (SEQ / CH) * NG;
    const u32x4 zero = {0u, 0u, 0u, 0u};
    for (int it = gtid; it < NITEM; it += gthreads) {
        const int c8 = it % NG, t0 = tok0 + (it / NG) * CH, col = c8 * 8;
        float w0[8], w1[8], w2[8];
#pragma unroll
        for (int e = 0; e < 8; e += 4) { *(f32x4*)(w0 + e) = *(const f32x4*)(cw + col + e); *(f32x4*)(w1 + e) = *(const f32x4*)(cw + DM + col + e); *(f32x4*)(w2 + e) = *(const f32x4*)(cw + 2 * DM + col + e); }
        float zp[8], zc[8];
        {
            const bf16_t* r = U + (size_t)(t0 - 1) * NA_N + col;
            u32x4 pa = zero, pb = zero;
            if ((t0 % SEQ) != 0) { pa = *(const u32x4*)(r + DM); pb = *(const u32x4*)(r + 2 * DM); }
            const u32x4 ca = *(const u32x4*)(r + NA_N + DM), cb = *(const u32x4*)(r + NA_N + 2 * DM);
            float a[8], b[8]; unpack8(pa, a); unpack8(pb, b);
#pragma unroll
            for (int e = 0; e < 8; ++e) zp[e] = a[e] * b[e];
            unpack8(ca, a); unpack8(cb, b);
#pragma unroll
            for (int e = 0; e < 8; ++e) zc[e] = a[e] * b[e];
        }
        for (int k = 0; k < CH / R; ++k) {
            u32x4 na[R], nb[R], gbv[R];
#pragma unroll
            for (int r_ = 0; r_ < R; ++r_) { const int t = t0 + k * R + r_; const bf16_t* r = U + (size_t)t * NA_N + col;
                gbv[r_] = *(const u32x4*)r;
                if (((t + 1) % SEQ) != 0) { na[r_] = *(const u32x4*)(r + NA_N + DM); nb[r_] = *(const u32x4*)(r + NA_N + 2 * DM); } else { na[r_] = zero; nb[r_] = zero; } }
#pragma unroll
            for (int r_ = 0; r_ < R; ++r_) { const int t = t0 + k * R + r_;
                float a[8], b[8], zn[8], gb[8], y[8]; unpack8(na[r_], a); unpack8(nb[r_], b); unpack8(gbv[r_], gb);
#pragma unroll
                for (int e = 0; e < 8; ++e) zn[e] = a[e] * b[e];
#pragma unroll
                for (int e = 0; e < 8; ++e) y[e] = gb[e] * (w0[e] * zp[e] + w1[e] * zc[e] + w2[e] * zn[e]);
                *(u32x4*)(Y + (size_t)t * DM + col) = pack8(y);
#pragma unroll
                for (int e = 0; e < 8; ++e) { zp[e] = zc[e]; zc[e] = zn[e]; } }
        }
    }
}

__device__ __forceinline__ void glu_fix_phase(const bf16_t* RAW, const float* __restrict__ cw, const float* __restrict__ cb, bf16_t* ACT, int gtid, int gthreads, int blk0) {
    constexpr int NG = DFF / 8, NITEM = (SEQ / 64) * 2 * NG;
    const u32x4 zero = {0u, 0u, 0u, 0u};
    for (int it = gtid; it < NITEM; it += gthreads) {
        const int c8 = it % NG, rest = it / NG, which = rest & 1, blk = blk0 + (rest >> 1), col = c8 * 8;
        const int t = 64 * blk + (which ? 63 : 0);
        const bf16_t* rc = RAW + ((size_t)blk * 4 + (which ? 3 : 0)) * UP_N + col;
        const bf16_t* rp = which ? rc - UP_N : rc - UP_N;
        const bf16_t* rn = which ? rc + UP_N : rc + UP_N;
        const bool has_p = which ? true : (t % SEQ) != 0, has_n = which ? ((t + 1) % SEQ) != 0 : true;
        u32x4 gp = zero, up = zero, gn = zero, un = zero;
        if (has_p) { gp = *(const u32x4*)rp; up = *(const u32x4*)(rp + DFF); }
        if (has_n) { gn = *(const u32x4*)rn; un = *(const u32x4*)(rn + DFF); }
        const u32x4 gc = *(const u32x4*)rc, uc = *(const u32x4*)(rc + DFF);
        float a[8], b[8], c[8], y[8], w0[8], w1[8], w2[8], bb[8], hg[8];
#pragma unroll
        for (int e = 0; e < 8; e += 4) { *(f32x4*)(w0 + e) = *(const f32x4*)(cw + col + e); *(f32x4*)(w1 + e) = *(const f32x4*)(cw + UP_N + col + e); *(f32x4*)(w2 + e) = *(const f32x4*)(cw + 2 * UP_N + col + e); *(f32x4*)(bb + e) = *(const f32x4*)(cb + col + e); }
        unpack8(gp, a); unpack8(gc, b); unpack8(gn, c);
#pragma unroll
        for (int e = 0; e < 8; ++e) hg[e] = w0[e] * a[e] + w1[e] * b[e] + w2[e] * c[e] + bb[e];
#pragma unroll
        for (int e = 0; e < 8; e += 4) { *(f32x4*)(w0 + e) = *(const f32x4*)(cw + DFF + col + e); *(f32x4*)(w1 + e) = *(const f32x4*)(cw + UP_N + DFF + col + e); *(f32x4*)(w2 + e) = *(const f32x4*)(cw + 2 * UP_N + DFF + col + e); *(f32x4*)(bb + e) = *(const f32x4*)(cb + DFF + col + e); }
        unpack8(up, a); unpack8(uc, b); unpack8(un, c);
#pragma unroll
        for (int e = 0; e < 8; ++e) { const float hu = w0[e] * a[e] + w1[e] * b[e] + w2[e] * c[e] + bb[e];
            const float sg = __builtin_amdgcn_rcpf(1.f + __builtin_amdgcn_exp2f(-1.4426950408889634f * hg[e])); y[e] = hg[e] * sg * hu; }
        *(u32x4*)(ACT + (size_t)t * DFF + col) = pack8(y);
    }
}

__device__ __forceinline__ void gqa_prep_phase(bf16_t* QKVg, const float* __restrict__ qn, const float* __restrict__ kn, int gw, int ngw, int lane, int tok0) {
    bf16_t* QKV = QKVg + (size_t)tok0 * GQ_N;
    const int sub = lane & 15, q4 = lane >> 4, sec = sub >> 3, half = (sub >> 2) & 1, i0 = 8 * (sub & 3);
    float inv[8], gq[8], gk[8], gqp[8], gkp[8];
#pragma unroll
    for (int j = 0; j < 8; ++j) { inv[j] = __builtin_amdgcn_exp2f(-(float)(i0 + j) * (13.287712379549449f / 32.f)) * 0.15915494309189535f;
        gq[j] = qn[8 * sub + j]; gqp[j] = qn[8 * (sub ^ 4) + j]; gk[j] = kn[8 * sub + j]; gkp[j] = kn[8 * (sub ^ 4) + j]; }
    const float sgn = half ? 1.f : -1.f;
    constexpr int NSTEP = SEQ * 20 / 4;
    int st = gw;
    u32x4 raw = {0u, 0u, 0u, 0u};
    if (st < NSTEP) { const int it = st * 4 + q4; raw = *(const u32x4*)(QKV + (size_t)(it / 20) * GQ_N + (it % 20) * HD + 8 * sub); }
    for (; st < NSTEP; st += ngw) {
        const int it = st * 4 + q4, t = it / 20, hh = it % 20;
        bf16_t* p = QKV + (size_t)t * GQ_N + hh * HD + 8 * sub;
        u32x4 nraw = {0u, 0u, 0u, 0u};
        if (st + ngw < NSTEP) { const int it2 = (st + ngw) * 4 + q4; nraw = *(const u32x4*)(QKV + (size_t)(it2 / 20) * GQ_N + (it2 % 20) * HD + 8 * sub); }
        float x[8], xp[8], o[8]; unpack8(raw, x);
        u32x4 praw; praw.x = shxu<4>(raw.x); praw.y = shxu<4>(raw.y); praw.z = shxu<4>(raw.z); praw.w = shxu<4>(raw.w);
        unpack8(praw, xp);
        float ss = 0.f;
#pragma unroll
        for (int j = 0; j < 8; ++j) ss += x[j] * x[j];
        ss += shx<1>(ss); ss += shx<2>(ss); ss += shx<4>(ss); ss += shx<8>(ss);
        const float rstd = rsqrtf(ss * (1.f / HD) + EPS);
        const int pos = t % SEQ; const float pf = (float)(sec == 0 ? pos / GRID_W : pos % GRID_W);
        const bool isq = hh < 16;
#pragma unroll
        for (int j = 0; j < 8; ++j) { const float y = x[j] * rstd * (isq ? gq[j] : gk[j]), yp = xp[j] * rstd * (isq ? gqp[j] : gkp[j]);
            const float rev = pf * inv[j]; const float sn = __builtin_amdgcn_sinf(rev), cs = __builtin_amdgcn_cosf(rev);
            o[j] = y * cs + sgn * yp * sn; }
        *(u32x4*)p = pack8(o);
        raw = nraw;
    }
}

#define XB_TMO      128
#define XB_XCNT(j)  (256  + 64 * (j))
#define XB_XSUB(j)  (1280 + 64 * (j))
#define XB_XGEN(j)  (2304 + 64 * (j))
#define XB_TOP      3328
#define XB_TOPGEN   3392
#define XCD_BAR_WORDS 3456
#define XB_SPIN_CAP (1u << 20)
__device__ __forceinline__ unsigned xb_ld(unsigned* p)              { return __hip_atomic_load(p, __ATOMIC_RELAXED, __HIP_MEMORY_SCOPE_AGENT); }
__device__ __forceinline__ unsigned xb_add(unsigned* p, unsigned v) { return __hip_atomic_fetch_add(p, v, __ATOMIC_RELAXED, __HIP_MEMORY_SCOPE_AGENT); }
__device__ __forceinline__ unsigned xb_xcc_id() { return (unsigned)__builtin_amdgcn_s_getreg((3 << 11) | 20) & 0xFu; }
#define XB_SPIN(cond, bar) do { unsigned _sp = 0; while (cond) { __builtin_amdgcn_s_sleep(1); \
    if ((++_sp & 255u) == 0u) { if (xb_ld(&(bar)[XB_TMO])) break; if (_sp > XB_SPIN_CAP) { atomicAdd(&(bar)[XB_TMO], 1u); break; } } } } while (0)
struct XcdBarrier { unsigned* bar; unsigned x; volatile LAS unsigned* st; };
__device__ __forceinline__ XcdBarrier xcd_barrier_post(unsigned* bar, volatile LAS unsigned* st) {
    XcdBarrier b; b.bar = bar; b.x = xb_xcc_id(); b.st = st;
    if (threadIdx.x == 0) (void)xb_add(&bar[XB_XCNT(b.x)], 1u);
    return b;
}
__device__ __forceinline__ void xcd_barrier_complete(unsigned* bar, unsigned x, unsigned& nloc, unsigned& nx) {
    const unsigned G = 256u;
    unsigned sum, cnt, mine, sp = 0u;
    for (;;) {
        sum = 0u; cnt = 0u; mine = 0u;
#pragma unroll
        for (unsigned j = 0; j < 16; ++j) { const unsigned c = xb_ld(&bar[XB_XCNT(j)]); sum += c; cnt += (c > 0u) ? 1u : 0u; mine = (j == x) ? c : mine; }
        if (sum == G) break;
        __builtin_amdgcn_s_sleep(1);
        if ((++sp & 255u) == 0u) { if (xb_ld(&bar[XB_TMO])) break; if (sp > XB_SPIN_CAP) { atomicAdd(&bar[XB_TMO], 1u); break; } }
    }
    nloc = mine > 0u ? mine : 1u; nx = cnt > 0u ? cnt : 1u;
}
__device__ __forceinline__ void xcd_barrier(const XcdBarrier& b, bool t0) {
    asm volatile("s_waitcnt vmcnt(0)" ::: "memory");
    __syncthreads();
    if (t0) {
        unsigned* bar = b.bar;
        __builtin_amdgcn_s_waitcnt(0);
        unsigned nloc = b.st[0], nx = b.st[1];
        if (nloc == 0u) { xcd_barrier_complete(bar, b.x, nloc, nx); b.st[0] = nloc; b.st[1] = nx; }
        const unsigned old = xb_add(&bar[XB_XSUB(b.x)], 1u);
        const unsigned gen = old / nloc;
        if (old + 1u == (gen + 1u) * nloc) {
            __builtin_amdgcn_fence(__ATOMIC_RELEASE, "agent");
            asm volatile("s_waitcnt vmcnt(0)" ::: "memory");
            const unsigned og = xb_add(&bar[XB_TOP], 1u);
            const unsigned tg = og / nx;
            if (og + 1u == (tg + 1u) * nx) xb_add(&bar[XB_TOPGEN], 1u);
            else XB_SPIN(xb_ld(&bar[XB_TOPGEN]) == tg, bar);
            __builtin_amdgcn_fence(__ATOMIC_ACQUIRE, "agent");
            xb_add(&bar[XB_XGEN(b.x)], 1u);
            asm volatile("s_waitcnt vmcnt(0)" ::: "memory");
        } else {
            XB_SPIN(xb_ld(&bar[XB_XGEN(b.x)]) == gen, bar);
            __builtin_amdgcn_fence(__ATOMIC_ACQUIRE, "agent");
            asm volatile("s_waitcnt vmcnt(0)" ::: "memory");
        }
    }
    __syncthreads();
}

__device__ __forceinline__ void xcc_local_barrier(unsigned* bar, unsigned x, unsigned nloc, bool t0) {
    asm volatile("s_waitcnt vmcnt(0)" ::: "memory");
    __syncthreads();
    if (t0) {
        __builtin_amdgcn_s_waitcnt(0);
        const unsigned old = xb_add(&bar[XB_XSUB(x)], 1u);
        const unsigned gen = old / nloc;
        if (old + 1u == (gen + 1u) * nloc) xb_add(&bar[XB_XGEN(x)], 1u);
        else XB_SPIN(xb_ld(&bar[XB_XGEN(x)]) == gen, bar);
        __builtin_amdgcn_fence(__ATOMIC_ACQUIRE, "agent");
        asm volatile("s_waitcnt vmcnt(0)" ::: "memory");
    }
    __syncthreads();
}

__device__ __forceinline__ int ctlw_read(LAS unsigned char* ldsl, int idx) { int off = CTLW_OFF + 4 * idx; asm volatile("" : "+v"(off)); return __builtin_amdgcn_readfirstlane((int)*(volatile LAS unsigned*)(ldsl + off)); }

typedef const __attribute__((address_space(4))) Params* CParams;
__device__ __forceinline__ CParams kp() { CParams q = (CParams)__builtin_amdgcn_kernarg_segment_ptr(); asm volatile("" : "+s"(q)); return q; }
#define LANE_ (tid_fresh(wave_s) & 63)
#define WAVE_ (wave_s)
#define GW_ ((int)blockIdx.x * NWAVES + WAVE_)
#define NGW_ (256 * NWAVES)
#define GTID_ ((int)blockIdx.x * NTHREADS + tid_fresh(wave_s))
#define GTHR_ (256 * NTHREADS)
#define CTLW_ ((volatile LAS unsigned*)(ldsl + CTLW_OFF))
#define VX_ ctlw_read(ldsl, 2)
#define VR_ ctlw_read(ldsl, 3)
#define LGW_ (VR_ * NWAVES + WAVE_)
#define LNGW_ (32 * NWAVES)
#define LGTID_ (VR_ * NTHREADS + tid_fresh(wave_s))
#define LGTHR_ (32 * NTHREADS)
#define TOK0_ (VX_ * SEQ)
#define ACTM_ ((bf16_t*)(kp()->ws + WS_ACT) + (size_t)VX_ * SEQ * (DFF - DM))
#define BIGG_ ((bf16_t*)(kp()->ws + WS_BIG) + (size_t)VX_ * SEQ * (NA_N - GQ_N))

__global__ void __launch_bounds__(NTHREADS, 2) fwd_megakernel(Params p_unused) {
    extern __shared__ __attribute__((aligned(16))) unsigned char lds[];
    cg::grid_group grid = cg::this_grid();
    LAS unsigned char* ldsl = (LAS unsigned char*)lds;
    constexpr int G = 256;
    const int wave_s = __builtin_amdgcn_readfirstlane(threadIdx.x >> 6);
    if (threadIdx.x < 8) ((volatile LAS unsigned*)(ldsl + CTLW_OFF))[threadIdx.x] = 0u;
    __syncthreads();
    if (threadIdx.x == 0) {
        unsigned* bar = (unsigned*)(kp()->ws + WS_CTL); const unsigned x = xb_xcc_id();
        const unsigned rank = xb_add(&bar[XB_XCNT(x)], 1u);
        CTLW_[2] = x; CTLW_[3] = rank;
    }
#define XBAR() do { if (ctlw_read(ldsl, 4) != 0) xcc_local_barrier((unsigned*)(kp()->ws + WS_CTL), (unsigned)VX_, 32u, tid_fresh(wave_s) == 0); \
    else { XcdBarrier xb_; xb_.bar = (unsigned*)(kp()->ws + WS_CTL); xb_.x = xb_xcc_id(); xb_.st = (volatile LAS unsigned*)(ldsl + CTLW_OFF); xcd_barrier(xb_, tid_fresh(wave_s) == 0); } } while (0)

    {
        const int lane = LANE_; LAS float* scr = (LAS float*)(ldsl + WAVE_ * 8704);
        unsigned char* ws = kp()->ws;
        convert_matrix(kp()->na_w_qkv, kp()->mix_norm, DM, NA_N, (bf16_t*)(ws + WS_NAQKV), scr, GW_, NGW_, LANE_);
        convert_matrix(kp()->na_w_qkv + (size_t)DM * NA_N, kp()->mix_norm + 3 * DM, DM, NA_N, (bf16_t*)(ws + WS_NAQKV + SZ_W6144), scr, GW_, NGW_, LANE_);
        convert_matrix(kp()->na_w_o, nullptr, DM, DM, (bf16_t*)(ws + WS_NAO), scr, GW_, NGW_, LANE_);
        convert_matrix(kp()->na_w_o + (size_t)DM * DM, nullptr, DM, DM, (bf16_t*)(ws + WS_NAO + SZ_W2048), scr, GW_, NGW_, LANE_);
        convert_matrix(kp()->sc_w_in, kp()->mix_norm + DM, DM, NA_N, (bf16_t*)(ws + WS_SCIN), scr, GW_, NGW_, LANE_);
        convert_matrix(kp()->sc_w_out, nullptr, DM, DM, (bf16_t*)(ws + WS_SCOUT), scr, GW_, NGW_, LANE_);
        convert_matrix(kp()->gqa_w_qkv, kp()->mix_norm + 2 * DM, DM, GQ_N, (bf16_t*)(ws + WS_GQKV), scr, GW_, NGW_, LANE_);
        convert_matrix(kp()->gqa_w_o, nullptr, DM, DM, (bf16_t*)(ws + WS_GO), scr, GW_, NGW_, LANE_);
        for (int l = 0; l < DEPTH; ++l) {
            convert_matrix(kp()->ffn_w_up + (size_t)l * DM * UP_N, kp()->ffn_norm + l * DM, DM, UP_N, (bf16_t*)(ws + WS_UP + l * SZ_WUP), scr, GW_, NGW_, LANE_);
            convert_matrix(kp()->ffn_w_down + (size_t)l * DFF * DM, nullptr, DFF, DM, (bf16_t*)(ws + WS_DN + l * SZ_WDN), scr, GW_, NGW_, LANE_);
        }
        x_prep_rows(kp()->x, (bf16_t*)(ws + WS_XH), (float*)(ws + WS_RSTD), GW_, NGW_, LANE_);
    }
    if (kp()->ws == nullptr) grid.sync();
    { XcdBarrier xb_; xb_.bar = (unsigned*)(kp()->ws + WS_CTL); xb_.x = xb_xcc_id(); xb_.st = (volatile LAS unsigned*)(ldsl + CTLW_OFF); xcd_barrier(xb_, tid_fresh(wave_s) == 0); }
    {
        if (tid_fresh(wave_s) == 0) { unsigned* bar = (unsigned*)(kp()->ws + WS_CTL); bool ok = true;
            for (unsigned jj = 0; jj < 16; ++jj) ok = ok && (xb_ld(&bar[XB_XCNT(jj)]) == (jj < 8 ? 32u : 0u));
            if (ok) CTLW_[4] = 1u; else { CTLW_[2] = blockIdx.x % 8u; CTLW_[3] = blockIdx.x / 8u; CTLW_[4] = 0u; } }
        __syncthreads();
    }

    for (int layer = 0; layer < DEPTH; ++layer) {
        const int mixer = layer % 3, j = layer / 3;
        {
            unsigned char* ws = kp()->ws;
            const bf16_t* Wt = mixer == 0 ? (const bf16_t*)(ws + WS_NAQKV + j * SZ_W6144) : mixer == 1 ? (const bf16_t*)(ws + WS_SCIN) : (const bf16_t*)(ws + WS_GQKV);
            const int N = mixer == 2 ? GQ_N : NA_N;
            pg8::Gemm g{(const bf16_t*)(ws + WS_XH), Wt, MT, N, DM, (size_t)256 * DM * 2, (size_t)128 * DM * 2}; pg8::StaticOrder S; S.init(N, VX_, VR_);
            pg8::EpiBf16 E{mixer == 2 ? BIGG_ : (bf16_t*)(ws + WS_BIG), N, (const float*)(ws + WS_RSTD) + (size_t)(2 * layer) * MT};
            pg8::gemm_phase<pg8::EpiBf16>(ldsl, g, S, E, wave_s);
        }
        XBAR();
        if (mixer == 0) {
            for (int i = 0; i < 4; ++i) {
                const int v = VR_, rg = 2 * i + (v & 1), b = VX_, h = v >> 1;
                const int r0 = 4 * rg, kr0 = min(max(r0 - 4, 0), GRID_R - 8), klast = min(max(r0 - 1, 0), GRID_R - 8) + 7;
                int NT = klast - kr0 + 1; NT += (NT & 1);
                {
                    LAS float* btab = (LAS float*)(ldsl + att::SHM_BIAS);
                    const float* rpb = kp()->na_rpb + ((size_t)j * 16 + h) * 465;
                    for (int u = tid_fresh(wave_s); u < 15 * 128; u += NTHREADS) { const int dr = u >> 7; int d = (u & 127) - 48; d = d < 0 ? 0 : (d > 30 ? 30 : d); btab[u] = rpb[dr * 31 + d] * (1.f / att::SCALE); }
                }
                unsigned char* ws = kp()->ws;
                const bf16_t* base = (const bf16_t*)(ws + WS_BIG) + (size_t)b * SEQ * NA_N + h * HD;
                att::attn_body<true, NA_N, DM>(base + (size_t)r0 * GRID_W * NA_N, base + DM + (size_t)kr0 * GRID_W * NA_N, base + 2 * DM + (size_t)kr0 * GRID_W * NA_N,
                                               ACTM_ + ((size_t)b * SEQ + r0 * GRID_W) * DM + h * HD, NT, (char*)lds, r0, kr0, (const float*)(lds + att::SHM_BIAS), wave_s);
            }
        } else if (mixer == 1) {
            unsigned char* ws = kp()->ws;
            sc_conv_phase((const bf16_t*)(ws + WS_BIG), kp()->sc_conv_w, ACTM_, LGTID_, LGTHR_, TOK0_);
        } else {
            gqa_prep_phase(BIGG_, kp()->gqa_q_norm, kp()->gqa_k_norm, LGW_, LNGW_, LANE_, TOK0_);
            XBAR();
            for (int i = 0; i < 4; ++i) {
                const int w = VR_, b = VX_, kvh = i, h = kvh * 4 + (w >> 3), qb = w & 7;
                unsigned char* ws = kp()->ws;
                const bf16_t* base = BIGG_ + (size_t)b * SEQ * GQ_N;
                att::attn_body<false, GQ_N, DM>(base + (size_t)qb * 256 * GQ_N + h * HD, base + DM + kvh * HD, base + DM + 512 + kvh * HD,
                                                ACTM_ + ((size_t)b * SEQ + qb * 256) * DM + h * HD, SEQ / 64, (char*)lds, 0, 0, nullptr, wave_s);
            }
        }
        XBAR();
        {
            unsigned char* ws = kp()->ws;
            const bf16_t* Wt = mixer == 0 ? (const bf16_t*)(ws + WS_NAO + j * SZ_W2048) : mixer == 1 ? (const bf16_t*)(ws + WS_SCOUT) : (const bf16_t*)(ws + WS_GO);
            pg8::Gemm g{(const bf16_t*)ACTM_, Wt, MT, DM, DM, (size_t)256 * DM * 2, (size_t)128 * DM * 2}; pg8::StaticOrder S; S.init(DM, VX_, VR_);
            pg8::EpiRes E{(bf16_t*)(ws + WS_XH), DM, (float*)(ws + WS_SLOT) + (size_t)(2 * layer + 1) * 32 * MT, nullptr};
            pg8::gemm_phase<pg8::EpiRes>(ldsl, g, S, E, wave_s);
        }
        XBAR();
        rstd_pass((const float*)(kp()->ws + WS_SLOT) + (size_t)(2 * layer + 1) * 32 * MT, (float*)(kp()->ws + WS_RSTD) + (size_t)(2 * layer + 1) * MT, LGTID_, LGTHR_, TOK0_);
        XBAR();
        {
            unsigned char* ws = kp()->ws;
            pg8::Gemm g{(const bf16_t*)(ws + WS_XH), (const bf16_t*)(ws + WS_UP + layer * SZ_WUP), MT, UP_N, DM, (size_t)128 * DM * 2, (size_t)DFF * DM * 2}; pg8::StaticOrder S; S.init(UP_N, VX_, VR_);
            pg8::EpiGlu E{(bf16_t*)(ws + WS_ACT), (bf16_t*)(ws + WS_RAW), kp()->ffn_conv_w + (size_t)layer * 3 * UP_N, kp()->ffn_conv_b + (size_t)layer * UP_N, (const float*)(ws + WS_RSTD) + (size_t)(2 * layer + 1) * MT};
            pg8::gemm_phase<pg8::EpiGlu>(ldsl, g, S, E, wave_s);
        }
        XBAR();
        glu_fix_phase((const bf16_t*)(kp()->ws + WS_RAW), kp()->ffn_conv_w + (size_t)layer * 3 * UP_N, kp()->ffn_conv_b + (size_t)layer * UP_N, (bf16_t*)(kp()->ws + WS_ACT), LGTID_, LGTHR_, VX_ * (SEQ / 64));
        XBAR();
        {
            unsigned char* ws = kp()->ws;
            pg8::Gemm g{(const bf16_t*)(ws + WS_ACT), (const bf16_t*)(ws + WS_DN + layer * SZ_WDN), MT, DM, DFF, (size_t)256 * DFF * 2, (size_t)128 * DFF * 2}; pg8::StaticOrder S; S.init(DM, VX_, VR_);
            pg8::EpiRes E{(bf16_t*)(ws + WS_XH), DM, (float*)(ws + WS_SLOT) + (size_t)(2 * layer + 2) * 32 * MT, nullptr};
            pg8::gemm_phase<pg8::EpiRes>(ldsl, g, S, E, wave_s);
        }
        XBAR();
        if (layer + 1 < DEPTH) { rstd_pass((const float*)(kp()->ws + WS_SLOT) + (size_t)(2 * layer + 2) * 32 * MT, (float*)(kp()->ws + WS_RSTD) + (size_t)(2 * layer + 2) * MT, LGTID_, LGTHR_, TOK0_); XBAR(); }
    }
    rmsnorm_rows_f32((const bf16_t*)(kp()->ws + WS_XH), kp()->final_norm, kp()->out, LGW_, LNGW_, LANE_, TOK0_);
}

extern "C" void kernel_launch(void* const* d_in, const int* in_sizes, int n_in, void* d_out, int out_size, void* d_ws, size_t ws_size, hipStream_t stream) {
    static int grid_blocks = 0;
    if (grid_blocks == 0) {
        if (n_in != 18 || in_sizes[0] != MT * DM || out_size != MT * DM || ws_size < WS_END) {
            fprintf(stderr, "kernel_launch: unexpected shapes (n_in %d, in0 %d, out %d, ws %zu need %zu); nothing launched\n", n_in, n_in > 0 ? in_sizes[0] : -1, out_size, ws_size, (size_t)WS_END);
            grid_blocks = -1; return; }
        int dev = 0, cus = 0, per_cu = 0;
        (void)hipGetDevice(&dev);
        (void)hipDeviceGetAttribute(&cus, hipDeviceAttributeMultiprocessorCount, dev);
        if (hipFuncSetAttribute((const void*)fwd_megakernel, hipFuncAttributeMaxDynamicSharedMemorySize, LDS_BYTES) != hipSuccess) { fprintf(stderr, "kernel_launch: hipFuncSetAttribute failed\n"); grid_blocks = -1; return; }
        if (hipOccupancyMaxActiveBlocksPerMultiprocessor(&per_cu, (const void*)fwd_megakernel, NTHREADS, LDS_BYTES) != hipSuccess || per_cu < 1) { fprintf(stderr, "kernel_launch: occupancy query gave %d\n", per_cu); per_cu = 1; }
        (void)hipGetLastError();
        if (cus != 256) { fprintf(stderr, "kernel_launch: built for a 256-CU device, found %d CUs; nothing launched\n", cus); grid_blocks = -1; return; }
        grid_blocks = cus * 1;
        fprintf(stderr, "kernel_launch: cus %d per_cu %d grid %d\n", cus, per_cu, grid_blocks);
    }
    if (grid_blocks < 0) return;
    Params p{};
    p.x = (const float*)d_in[0]; p.mix_norm = (const float*)d_in[1]; p.ffn_norm = (const float*)d_in[2]; p.final_norm = (const float*)d_in[3];
    p.na_w_qkv = (const float*)d_in[4]; p.na_rpb = (const float*)d_in[5]; p.na_w_o = (const float*)d_in[6];
    p.sc_w_in = (const float*)d_in[7]; p.sc_conv_w = (const float*)d_in[8]; p.sc_w_out = (const float*)d_in[9];
    p.gqa_w_qkv = (const float*)d_in[10]; p.gqa_q_norm = (const float*)d_in[11]; p.gqa_k_norm = (const float*)d_in[12]; p.gqa_w_o = (const float*)d_in[13];
    p.ffn_w_up = (const float*)d_in[14]; p.ffn_conv_w = (const float*)d_in[15]; p.ffn_conv_b = (const float*)d_in[16]; p.ffn_w_down = (const float*)d_in[17];
    p.out = (float*)d_out; p.ws = (unsigned char*)d_ws;
    if (hipMemsetAsync((char*)d_ws + WS_CTL, 0, CTL_BYTES, stream) != hipSuccess) { fprintf(stderr, "kernel_launch: memset failed\n"); return; }
    void* args[] = {&p};
    hipError_t e = hipLaunchCooperativeKernel((const void*)fwd_megakernel, dim3(grid_blocks), dim3(NTHREADS), args, LDS_BYTES, stream);
    if (e != hipSuccess) fprintf(stderr, "cooperative launch failed: %s (grid %d)\n", hipGetErrorString(e), grid_blocks);
}
```

```cpp
#include <hip/hip_runtime.h>
#include <hip/hip_cooperative_groups.h>
#include <cstdio>
#include <cstdint>
namespace cg = cooperative_groups;

#define LAS __attribute__((address_space(3)))
typedef unsigned short bf16_t;
typedef short bf16x8 __attribute__((ext_vector_type(8)));
typedef short s16x4 __attribute__((ext_vector_type(4)));
typedef float f32x4 __attribute__((ext_vector_type(4)));
typedef float f32x2 __attribute__((ext_vector_type(2)));
typedef float f32x16 __attribute__((ext_vector_type(16)));
typedef unsigned u32x4 __attribute__((ext_vector_type(4)));
typedef unsigned u32x2 __attribute__((ext_vector_type(2)));

constexpr int DM = 2048, NB = 8, SEQ = 2048, MT = NB * SEQ  , DEPTH = 4, HD = 128;
constexpr int GRID_W = 64, GRID_R = SEQ / GRID_W  ;
constexpr int NA_N = 3 * DM  , GQ_N = 3072, DFF = 5632, UP_N = 2 * DFF  ;
constexpr float EPS = 1e-6f;
constexpr int RTAB_OFF = 132096;

constexpr size_t SZ_W6144 = (size_t)6144 * 2048 * 2, SZ_W2048 = (size_t)2048 * 2048 * 2, SZ_W3072 = (size_t)3072 * 2048 * 2;
constexpr size_t SZ_WUP = (size_t)UP_N * 2048 * 2, SZ_WDN = (size_t)2048 * DFF * 2;
constexpr size_t WS_NAQKV = 0;
constexpr size_t WS_NAO = WS_NAQKV + 2 * SZ_W6144;
constexpr size_t WS_SCIN = WS_NAO + 2 * SZ_W2048;
constexpr size_t WS_SCOUT = WS_SCIN + SZ_W6144;
constexpr size_t WS_GQKV = WS_SCOUT + SZ_W2048;
constexpr size_t WS_GO = WS_GQKV + SZ_W3072;
constexpr size_t WS_UP = WS_GO + SZ_W2048;
constexpr size_t WS_DN = WS_UP + 4 * SZ_WUP;
constexpr size_t WS_XN = WS_DN + 4 * SZ_WDN;
constexpr size_t WS_BIG = WS_XN + (size_t)MT * DM * 2;
constexpr size_t WS_ACT = WS_BIG + (size_t)MT * UP_N * 2;
constexpr size_t WS_XH = WS_ACT + (size_t)MT * DFF * 2;
constexpr size_t WS_CTL = WS_XH + (size_t)MT * DM * 2;
constexpr size_t CTL_BYTES = 16384;
constexpr size_t WS_RAW = WS_CTL + CTL_BYTES;
constexpr size_t WS_SLOT = WS_RAW + (size_t)(MT / 64) * 4 * UP_N * 2;
constexpr size_t WS_RSTD = WS_SLOT + (size_t)9 * 32 * MT * 4;
constexpr size_t WS_END = WS_RSTD + (size_t)9 * MT * 4;

__device__ __forceinline__ unsigned cvt_pk_bf16(float lo, float hi) { unsigned r; asm volatile("v_cvt_pk_bf16_f32 %0, %1, %2" : "=v"(r) : "v"(lo), "v"(hi)); return r; }
__device__ __forceinline__ float bf_lo(unsigned w) { return __uint_as_float(w << 16); }
__device__ __forceinline__ float bf_hi(unsigned w) { return __uint_as_float(w & 0xffff0000u); }
template <int M> __device__ __forceinline__ float shx(float v) { return __int_as_float(__builtin_amdgcn_ds_swizzle(__float_as_int(v), (M << 10) | 0x1f)); }
template <int M> __device__ __forceinline__ unsigned shxu(unsigned v) { return (unsigned)__builtin_amdgcn_ds_swizzle((int)v, (M << 10) | 0x1f); }
__device__ __forceinline__ float add_x32(float v) { auto rr = __builtin_amdgcn_permlane32_swap(__float_as_uint(v), __float_as_uint(v), false, false); return __uint_as_float(rr[0]) + __uint_as_float(rr[1]); }
__device__ __forceinline__ float wave_sum(float v) {
    v += shx<1>(v); v += shx<2>(v); v += shx<4>(v); v += shx<8>(v); v += shx<16>(v);
    return add_x32(v);
}

__device__ __forceinline__ int tid_fresh(int wave_s) { int t = wave_s * 64 + (int)__builtin_amdgcn_mbcnt_hi(~0u, __builtin_amdgcn_mbcnt_lo(~0u, 0u)); asm volatile("" : "+v"(t)); return t; }

namespace pg8 {
constexpr int BM = 256, BK = 64, HALF = 128, HTB = HALF * BK * 2, STAGE_BYTES = 8 * HTB, NXCD = 8, WGM = 8;
__host__ __device__ __forceinline__ int lds_byte(int r, int c) { const int st = (r >> 4) * 2 + (c >> 5), rr = r & 15, cc = c & 31, ob = rr * 64 + cc * 2; return st * 1024 + (ob ^ (((ob >> 9) & 1) << 5)); }
__host__ __device__ __forceinline__ void stage_rc(int b, int& R, int& C) { const int st = b / 1024, sb = b % 1024, swz = sb ^ (((sb >> 9) & 1) << 5); R = (st >> 1) * 16 + swz / 64; C = (st & 1) * 32 + (swz % 64) / 2; }
__host__ __device__ __forceinline__ int perm32(int rho) { const int n = rho >> 4, i = rho & 15; return 8 * (i >> 2) + 4 * n + (i & 3); }
struct Unit { int pm, pn; };
struct Gemm { const bf16_t* A; const bf16_t* Bt; int M, N, K; size_t b_unit, b_half; };
struct StaticOrder {
    int nloc, X, R;
    __host__ __device__ void init(int N, int X_, int R_) { nloc = 8 * (N / BM); X = X_; R = R_; }
    __host__ __device__ bool next(int i, Unit& u) const {
        const int id = i * 32 + R; if (id >= nloc) return false;
        u.pm = 8 * X + (id & 7); u.pn = id >> 3; return true;
    }
};
struct EpiBf16 {
    static constexpr bool PERM = true, RSTD = true;
    bf16_t* O; int ldc; const float* rstd;
    __device__ __forceinline__ void operator()(f32x4 (&acc)[2][2][4][2], const Unit& u, int wr, int wc, int fr, int fq, const LAS float* rtab) const {
        const int row0 = u.pm * BM + wr * 64 + fr, col0 = u.pn * BM + wc * 32 + 8 * fq;
#pragma unroll
        for (int ai = 0; ai < 2; ++ai)
#pragma unroll
            for (int m = 0; m < 4; ++m) { bf16_t* rowp = O + (size_t)(row0 + ai * HALF + m * 16) * ldc + col0; const float r = rtab[ai * HALF + wr * 64 + m * 16 + fr];
#pragma unroll
                for (int bj = 0; bj < 2; ++bj) { const f32x4 v0 = acc[ai][bj][m][0] * r, v1 = acc[ai][bj][m][1] * r;
                    u32x4 w; w.x = cvt_pk_bf16(v0[0], v0[1]); w.y = cvt_pk_bf16(v0[2], v0[3]); w.z = cvt_pk_bf16(v1[0], v1[1]); w.w = cvt_pk_bf16(v1[2], v1[3]);
                    *(u32x4*)(rowp + bj * HALF) = w; } }
    }
};
struct EpiRes {
    static constexpr bool PERM = true, RSTD = false;
    bf16_t* h; int ldc; float* slot; const float* rstd;
    __device__ __forceinline__ void operator()(f32x4 (&acc)[2][2][4][2], const Unit& u, int wr, int wc, int fr, int fq, const LAS float*) const {
        const int row0 = u.pm * BM + wr * 64 + fr, col0 = u.pn * BM + wc * 32 + 8 * fq;
        float ssq[2][4];
#pragma unroll
        for (int ai = 0; ai < 2; ++ai) {
            u32x4 bs[4][2];
#pragma unroll
            for (int m = 0; m < 4; ++m)
#pragma unroll
                for (int bj = 0; bj < 2; ++bj) bs[m][bj] = *(const u32x4*)(h + (size_t)(row0 + ai * HALF + m * 16) * ldc + col0 + bj * HALF);
#pragma unroll
            for (int m = 0; m < 4; ++m) { float sq = 0.f;
#pragma unroll
                for (int bj = 0; bj < 2; ++bj) { const u32x4 b = bs[m][bj]; const f32x4 a0 = acc[ai][bj][m][0], a1 = acc[ai][bj][m][1];
                    const float v0 = bf_lo(b.x) + a0[0], v1 = bf_hi(b.x) + a0[1], v2 = bf_lo(b.y) + a0[2], v3 = bf_hi(b.y) + a0[3];
                    const float v4 = bf_lo(b.z) + a1[0], v5 = bf_hi(b.z) + a1[1], v6 = bf_lo(b.w) + a1[2], v7 = bf_hi(b.w) + a1[3];
                    u32x4 w; w.x = cvt_pk_bf16(v0, v1); w.y = cvt_pk_bf16(v2, v3); w.z = cvt_pk_bf16(v4, v5); w.w = cvt_pk_bf16(v6, v7);
                    *(u32x4*)(h + (size_t)(row0 + ai * HALF + m * 16) * ldc + col0 + bj * HALF) = w;
                    sq += (v0 * v0 + v1 * v1) + (v2 * v2 + v3 * v3) + (v4 * v4 + v5 * v5) + (v6 * v6 + v7 * v7); }
                sq += shx<16>(sq); sq = add_x32(sq); ssq[ai][m] = sq; }
            asm volatile("" ::: "memory");
        }
#pragma unroll
        for (int k = 0; k < 2; ++k) { const float v = fq == 0 ? ssq[k][0] : fq == 1 ? ssq[k][1] : fq == 2 ? ssq[k][2] : ssq[k][3];
            slot[(size_t)(u.pn * 4 + wc) * MT + row0 + k * HALF + fq * 16] = v; }
    }
};

template <int CTRL> __device__ __forceinline__ float dppz(float v) { return __int_as_float(__builtin_amdgcn_update_dpp(0, __float_as_int(v), CTRL, 0xf, 0xf, true)); }
struct EpiGlu {
    static constexpr bool PERM = true, RSTD = true;
    bf16_t* act; bf16_t* raw; const float* cw; const float* cb; const float* rstd;
    __device__ __forceinline__ void operator()(f32x4 (&acc)[2][2][4][2], const Unit& u, int wr, int wc, int fr, int fq, const LAS float* rtab) const {
        const int c0 = u.pn * 128 + wc * 32 + 8 * fq;
#pragma unroll
        for (int ai = 0; ai < 2; ++ai)
#pragma unroll
            for (int m = 0; m < 4; ++m) { const float r = rtab[ai * HALF + wr * 64 + m * 16 + fr];
#pragma unroll
                for (int bj = 0; bj < 2; ++bj)
#pragma unroll
                    for (int n = 0; n < 2; ++n) acc[ai][bj][m][n] = acc[ai][bj][m][n] * r; }
#pragma unroll
        for (int ai = 0; ai < 2; ++ai) {
            const int blk = (u.pm * BM + ai * HALF + wr * 64) >> 6;
            if (fr < 2) { bf16_t* rp = raw + ((size_t)blk * 4 + fr) * UP_N + c0;
                const f32x4 g0 = acc[ai][0][0][0], g1 = acc[ai][0][0][1], u0 = acc[ai][1][0][0], u1 = acc[ai][1][0][1];
                u32x4 w; w.x = cvt_pk_bf16(g0[0], g0[1]); w.y = cvt_pk_bf16(g0[2], g0[3]); w.z = cvt_pk_bf16(g1[0], g1[1]); w.w = cvt_pk_bf16(g1[2], g1[3]); *(u32x4*)rp = w;
                w.x = cvt_pk_bf16(u0[0], u0[1]); w.y = cvt_pk_bf16(u0[2], u0[3]); w.z = cvt_pk_bf16(u1[0], u1[1]); w.w = cvt_pk_bf16(u1[2], u1[3]); *(u32x4*)(rp + DFF) = w; }
            if (fr >= 14) { bf16_t* rp = raw + ((size_t)blk * 4 + (fr - 12)) * UP_N + c0;
                const f32x4 g0 = acc[ai][0][3][0], g1 = acc[ai][0][3][1], u0 = acc[ai][1][3][0], u1 = acc[ai][1][3][1];
                u32x4 w; w.x = cvt_pk_bf16(g0[0], g0[1]); w.y = cvt_pk_bf16(g0[2], g0[3]); w.z = cvt_pk_bf16(g1[0], g1[1]); w.w = cvt_pk_bf16(g1[2], g1[3]); *(u32x4*)rp = w;
                w.x = cvt_pk_bf16(u0[0], u0[1]); w.y = cvt_pk_bf16(u0[2], u0[3]); w.z = cvt_pk_bf16(u1[0], u1[1]); w.w = cvt_pk_bf16(u1[2], u1[3]); *(u32x4*)(rp + DFF) = w; }
        }
        u32x2 ypk[2][4];
#pragma unroll
        for (int n = 0; n < 2; ++n) {
            const int cn = c0 + 4 * n;
            const f32x4 wg0 = *(const f32x4*)(cw + cn), wg1 = *(const f32x4*)(cw + UP_N + cn), wg2 = *(const f32x4*)(cw + 2 * UP_N + cn), bg = *(const f32x4*)(cb + cn);
            const f32x4 wu0 = *(const f32x4*)(cw + DFF + cn), wu1 = *(const f32x4*)(cw + UP_N + DFF + cn), wu2 = *(const f32x4*)(cw + 2 * UP_N + DFF + cn), bu = *(const f32x4*)(cb + DFF + cn);
#pragma unroll
            for (int ai = 0; ai < 2; ++ai) {
                const int r64 = u.pm * BM + ai * HALF + wr * 64;
#pragma unroll
                for (int m = 0; m < 4; ++m) {
                    float y[4];
#pragma unroll
                    for (int jj = 0; jj < 4; ++jj) {
                        const float gc = acc[ai][0][m][n][jj], uc = acc[ai][1][m][n][jj];
                        const float gb = m > 0 ? acc[ai][0][m - 1][n][jj] : 0.f, ga = m < 3 ? acc[ai][0][m + 1][n][jj] : 0.f;
                        const float ub = m > 0 ? acc[ai][1][m - 1][n][jj] : 0.f, ua = m < 3 ? acc[ai][1][m + 1][n][jj] : 0.f;
                        const float gp = dppz<0x111>(gc) + dppz<0x10F>(gb), gn = dppz<0x101>(gc) + dppz<0x11F>(ga);
                        const float up = dppz<0x111>(uc) + dppz<0x10F>(ub), un = dppz<0x101>(uc) + dppz<0x11F>(ua);
                        const float hg = wg0[jj] * gp + wg1[jj] * gc + wg2[jj] * gn + bg[jj];
                        const float hu = wu0[jj] * up + wu1[jj] * uc + wu2[jj] * un + bu[jj];
                        const float sg = __builtin_amdgcn_rcpf(1.f + __builtin_amdgcn_exp2f(-1.4426950408889634f * hg));
                        y[jj] = hg * sg * hu; }
                    u32x2 pk; pk.x = cvt_pk_bf16(y[0], y[1]); pk.y = cvt_pk_bf16(y[2], y[3]);
                    if (n == 0) ypk[ai][m] = pk;
                    else {
                        const bool deferred = (m == 0 && fr == 0) || (m == 3 && fr == 15);
                        if (!deferred) { u32x4 w; w.x = ypk[ai][m].x; w.y = ypk[ai][m].y; w.z = pk.x; w.w = pk.y; *(u32x4*)(act + (size_t)(r64 + m * 16 + fr) * DFF + c0) = w; } }
                }
            }
        }
    }
};

template <class Epi, int STAG = 0>
__device__ __forceinline__ void gemm_phase(LAS unsigned char* lds, const Gemm g, const StaticOrder& S, const Epi& E, int wave_s) {
    const int tid = tid_fresh(wave_s), wid = __builtin_amdgcn_readfirstlane(tid >> 6), lane = tid & 63, wr = wid >> 2, wc = wid & 3, fr = lane & 15, fq = lane >> 4;
    const int K = g.K, nt = K / BK;
    unsigned voffA[2], voffB[2];
#pragma unroll
    for (int i = 0; i < 2; ++i) { int R, C; stage_rc(tid * 16 + i * 8192, R, C); const int Rb = Epi::PERM ? ((R & ~31) + perm32(R & 31)) : R;
        voffA[i] = (unsigned)(R * K + C) * 2u; voffB[i] = (unsigned)(Rb * K + C) * 2u; }
    const size_t kstep = (size_t)(BK * 2);
    const size_t hstep = (size_t)HALF * K * 2;
    const size_t tstep = 2 * hstep;
    const size_t bunit = g.b_unit, bh = g.b_half;
    const unsigned ldsw = (unsigned)wid * 1024u;
    const int aoff = lds_byte(wr * 64 + fr, fq * 8), boff = lds_byte(wc * 32 + fr, fq * 8);
#define PG8_SA(b, h) (((b) * 2 + (h)) * HTB)
#define PG8_SB(b, h) ((4 + (b) * 2 + (h)) * HTB)
#define PG8_STAGE(bufoff, gbase, voff) do { _Pragma("unroll") for (int _i = 0; _i < 2; ++_i) \
        __builtin_amdgcn_global_load_lds((const unsigned*)((const char*)(gbase) + (voff)[_i]), (LAS unsigned*)(lds + (bufoff) + ldsw + _i * 8192), 16, 0, 0); } while (0)
#define PG8_LDA(dst, b, h) do { _Pragma("unroll") for (int m = 0; m < 4; ++m) _Pragma("unroll") for (int k = 0; k < 2; ++k) dst[m][k] = *(const LAS bf16x8*)(lds + PG8_SA(b, h) + aoff + m * 2048 + k * 1024); } while (0)
#define PG8_LDB(dst, b, h) do { _Pragma("unroll") for (int n = 0; n < 2; ++n) _Pragma("unroll") for (int k = 0; k < 2; ++k) dst[n][k] = *(const LAS bf16x8*)(lds + PG8_SB(b, h) + boff + n * 2048 + k * 1024); } while (0)
#define PG8_MMA(ai, bj, At, Bt) do { __builtin_amdgcn_s_setprio(1); _Pragma("unroll") for (int m = 0; m < 4; ++m) _Pragma("unroll") for (int n = 0; n < 2; ++n) _Pragma("unroll") for (int k = 0; k < 2; ++k) \
        acc[ai][bj][m][n] = __builtin_amdgcn_mfma_f32_16x16x32_bf16(Bt[n][k], At[m][k], acc[ai][bj][m][n], 0, 0, 0); __builtin_amdgcn_s_setprio(0); } while (0)
#define PG8_WAIT_V(n) asm volatile("s_waitcnt vmcnt(" #n ")" ::: "memory")
#define PG8_WAIT_L(n) asm volatile("s_waitcnt lgkmcnt(" #n ")" ::: "memory")
#define PG8_BAR __builtin_amdgcn_s_barrier()
#define PG8_SCHED __builtin_amdgcn_sched_barrier(0)
    Unit cur, nxt; int ui = 0;
    if (!S.next(0, cur)) return;
    if constexpr (Epi::RSTD) {
        LAS float* tab = (LAS float*)(lds + RTAB_OFF);
        for (int idx = tid; idx < 11 * 256; idx += 512) { Unit uu; if (S.next(idx >> 8, uu)) tab[idx] = E.rstd[uu.pm * BM + (idx & 255)]; }
        asm volatile("s_waitcnt vmcnt(0) lgkmcnt(0)" ::: "memory"); __builtin_amdgcn_s_barrier(); asm volatile("" ::: "memory");
    }
    f32x4 acc[2][2][4][2];
#pragma unroll
    for (int a = 0; a < 2; ++a)
#pragma unroll
        for (int b = 0; b < 2; ++b)
#pragma unroll
            for (int m = 0; m < 4; ++m)
#pragma unroll
                for (int n = 0; n < 2; ++n) acc[a][b][m][n] = (f32x4){0.f, 0.f, 0.f, 0.f};
    bf16x8 At[4][2], B0[2][2], B1[2][2];
    const char* cA = (const char*)g.A + (size_t)cur.pm * tstep; const char* cB = (const char*)g.Bt + (size_t)cur.pn * bunit;
    PG8_STAGE(PG8_SB(0, 0), cB, voffB); PG8_STAGE(PG8_SB(0, 1), cB + bh, voffB); PG8_STAGE(PG8_SA(0, 0), cA, voffA); PG8_STAGE(PG8_SA(0, 1), cA + hstep, voffA);
    if (wr == 1) PG8_BAR;
    PG8_WAIT_V(2); PG8_BAR;
    PG8_STAGE(PG8_SB(1, 0), cB + kstep, voffB); PG8_STAGE(PG8_SA(1, 0), cA + kstep, voffA); PG8_STAGE(PG8_SB(1, 1), cB + bh + kstep, voffB);
    PG8_WAIT_V(6); PG8_BAR;
    for (;;) {
        const bool has_next = S.next(ui + 1, nxt);
        const char* nA = has_next ? (const char*)g.A + (size_t)nxt.pm * tstep : cA; const char* nB = has_next ? (const char*)g.Bt + (size_t)nxt.pn * bunit : cB;
        for (int t = 0; t < nt; t += 2) {
            const bool last = (t == nt - 2);
            const char* a1 = cA + (size_t)(t + 1) * kstep;
            const char* a2 = last ? nA : cA + (size_t)(t + 2) * kstep; const char* b2 = last ? nB : cB + (size_t)(t + 2) * kstep;
            const char* a3 = a2 + kstep; const char* b3 = b2 + kstep;
            PG8_LDB(B0, 0, 0); PG8_LDB(B1, 0, 1); PG8_SCHED; PG8_LDA(At, 0, 0); PG8_STAGE(PG8_SA(1, 1), a1 + hstep, voffA);
            PG8_WAIT_V(8); PG8_WAIT_L(0); PG8_BAR; PG8_MMA(0, 0, At, B0); PG8_MMA(0, 1, At, B1); PG8_BAR; PG8_SCHED;
            PG8_LDA(At, 0, 1); PG8_STAGE(PG8_SB(0, 0), b2, voffB); PG8_STAGE(PG8_SB(0, 1), b2 + bh, voffB); PG8_STAGE(PG8_SA(0, 0), a2, voffA);
            PG8_WAIT_V(8); PG8_WAIT_L(0); PG8_BAR; PG8_MMA(1, 0, At, B0); PG8_MMA(1, 1, At, B1); PG8_BAR; PG8_SCHED;
            PG8_LDB(B0, 1, 0); PG8_LDB(B1, 1, 1); PG8_SCHED; PG8_LDA(At, 1, 0); PG8_STAGE(PG8_SA(0, 1), a2 + hstep, voffA);
            PG8_WAIT_V(8); PG8_WAIT_L(0); PG8_BAR; PG8_MMA(0, 0, At, B0); PG8_MMA(0, 1, At, B1); PG8_BAR; PG8_SCHED;
            PG8_LDA(At, 1, 1); PG8_STAGE(PG8_SB(1, 0), b3, voffB); PG8_STAGE(PG8_SB(1, 1), b3 + bh, voffB); PG8_STAGE(PG8_SA(1, 0), a3, voffA);
            PG8_WAIT_V(8); PG8_WAIT_L(0); PG8_BAR; PG8_MMA(1, 0, At, B0); PG8_MMA(1, 1, At, B1); PG8_BAR; PG8_SCHED;
        }
        if (wr == 0) PG8_BAR;
        E(acc, cur, wr, wc, fr, fq, (const LAS float*)(lds + RTAB_OFF) + ui * 256);
        if (!has_next) break;
#pragma unroll
        for (int a = 0; a < 2; ++a)
#pragma unroll
            for (int b = 0; b < 2; ++b)
#pragma unroll
                for (int m = 0; m < 4; ++m)
#pragma unroll
                    for (int n = 0; n < 2; ++n) acc[a][b][m][n] = (f32x4){0.f, 0.f, 0.f, 0.f};
        cur = nxt; cA = nA; cB = nB; ++ui;
        if (wr == 1) PG8_BAR;
    }
    PG8_WAIT_V(0);
    PG8_BAR;
#undef PG8_SA
#undef PG8_SB
#undef PG8_STAGE
#undef PG8_LDA
#undef PG8_LDB
#undef PG8_MMA
#undef PG8_WAIT_V
#undef PG8_WAIT_L
#undef PG8_BAR
#undef PG8_SCHED
}
}

namespace att {
constexpr int D = 128, NW = 8, QBLK = 32, KVBLK = 64;
constexpr float SCALE = 0.088388347648318440f;
constexpr float THR = 8.f;
constexpr size_t SHM_V = KVBLK * D * 2, SHM_K = KVBLK * D * 2, SHM_ATTN = 2 * SHM_V + 2 * SHM_K + NW * 64 * 4;
constexpr size_t SHM_OST = 77312;
constexpr size_t SHM_BIAS = 69632;
#define KSWZ(row, colB) ((row) * 256 + ((colB) ^ (((row) & 7) << 4)))
#define SBAR() __builtin_amdgcn_sched_barrier(0)
__device__ __forceinline__ int crow(int r, int hi) { return (r & 3) + 8 * (r >> 2) + 4 * hi; }
__device__ __forceinline__ unsigned cvtpk(float lo, float hi) { unsigned r; asm volatile("v_cvt_pk_bf16_f32 %0, %1, %2" : "=v"(r) : "v"(lo), "v"(hi)); return r; }

__device__ __forceinline__ void partialSM(f32x16& p0, f32x16& p1, float& m_reg, float& mn, float& alpha) {
  constexpr float C = SCALE * 1.4426950408889634f;
  float pmax = p0[0];
#pragma unroll
  for (int r = 1; r < 16; ++r) pmax = fmaxf(pmax, p0[r]);
#pragma unroll
  for (int r = 0; r < 16; ++r) pmax = fmaxf(pmax, p1[r]);
  { auto rr = __builtin_amdgcn_permlane32_swap(__float_as_uint(pmax), __float_as_uint(pmax), false, false);
    pmax = fmaxf(__uint_as_float(rr[0]), __uint_as_float(rr[1])); }
  if (__builtin_expect(__all(pmax - m_reg <= THR / SCALE), 1)) { mn = m_reg; alpha = 1.f; }
  else { mn = fmaxf(m_reg, pmax); alpha = __builtin_amdgcn_exp2f((m_reg - mn) * C); m_reg = mn; }
  float mnC = -mn * C;
#pragma unroll
  for (int r = 0; r < 16; ++r) p0[r] = fmaf(p0[r], C, mnC);
#pragma unroll
  for (int r = 0; r < 16; ++r) p1[r] = fmaf(p1[r], C, mnC);
#pragma unroll
  for (int r = 0; r < 16; ++r) p0[r] = __builtin_amdgcn_exp2f(p0[r]);
}
__device__ __forceinline__ void finishSM(f32x16& p0, f32x16& p1, float alpha, float& l_reg, bf16x8& pa0, bf16x8& pa1, bf16x8& pa2, bf16x8& pa3) {
#pragma unroll
  for (int r = 0; r < 16; ++r) p1[r] = __builtin_amdgcn_exp2f(p1[r]);
  float ps = 0;
#pragma unroll
  for (int r = 0; r < 16; ++r) ps += p0[r];
#pragma unroll
  for (int r = 0; r < 16; ++r) ps += p1[r];
  { auto rr = __builtin_amdgcn_permlane32_swap(__float_as_uint(ps), __float_as_uint(ps), false, false);
    ps = __uint_as_float(rr[0]) + __uint_as_float(rr[1]); }
  l_reg = l_reg * alpha + ps;
#define PK4(P, BASE, OUT) do { unsigned a0 = cvtpk(P[BASE + 0], P[BASE + 1]), a1 = cvtpk(P[BASE + 2], P[BASE + 3]);   \
    unsigned b0 = cvtpk(P[BASE + 4], P[BASE + 5]), b1 = cvtpk(P[BASE + 6], P[BASE + 7]);                              \
    auto r0 = __builtin_amdgcn_permlane32_swap(a0, b0, false, false); auto r1 = __builtin_amdgcn_permlane32_swap(a1, b1, false, false); \
    u32x4 w = {r0[0], r1[0], r0[1], r1[1]}; OUT = *reinterpret_cast<bf16x8*>(&w); } while (0)
  PK4(p0, 0, pa0); PK4(p0, 8, pa1); PK4(p1, 0, pa2); PK4(p1, 8, pa3);
#undef PK4
}
__device__ __forceinline__ void qkt(f32x16& p0, f32x16& p1, const bf16_t* Ks, const bf16x8* qr, int r32, int hi) {
  p0 = f32x16{}; p1 = f32x16{};
#pragma unroll
  for (int d0 = 0; d0 < 8; ++d0) { int cb = (d0 * 16 + hi * 8) * 2;
    bf16x8 b0 = *reinterpret_cast<const bf16x8*>((const char*)Ks + KSWZ(r32, cb));
    bf16x8 b1 = *reinterpret_cast<const bf16x8*>((const char*)Ks + KSWZ(32 + r32, cb));
    p0 = __builtin_amdgcn_mfma_f32_32x32x16_bf16(b0, qr[d0], p0, 0, 0, 0);
    p1 = __builtin_amdgcn_mfma_f32_32x32x16_bf16(b1, qr[d0], p1, 0, 0, 0); }
}
__device__ __forceinline__ int v_st(int k, int c) { const int kk = (k & ~0xC) | ((k & 4) << 1) | ((k & 8) >> 1); return ((kk >> 3) * 4 + (c >> 5)) * 512 + ((kk & 7) * 32 + (c & 31)) * 2; }
__device__ __forceinline__ int v_rd_base(int lane) { return ((lane & 3) << 3) | (((lane >> 2) & 3) << 6) | (((lane >> 4) & 1) << 5) | (((lane >> 5) & 1) << 8); }
constexpr int v_rd_off(int d0, int ks, int half) { return d0 * 512 + ks * 4096 + half * 2048; }
template <int OFF> __device__ __forceinline__ s16x4 tr_read(int vb) {
  s16x4 r; asm volatile("ds_read_b64_tr_b16 %0, %1 offset:%2" : "=&v"(r) : "v"(vb), "i"(OFF) : "memory"); return r;
}
template <int D0> __device__ __forceinline__ void pv_one(f32x16& od, int vb, bf16x8 pa0, bf16x8 pa1, bf16x8 pa2, bf16x8 pa3) {
  const s16x4 l0 = tr_read<v_rd_off(D0, 0, 0)>(vb), h0 = tr_read<v_rd_off(D0, 0, 1)>(vb), l1 = tr_read<v_rd_off(D0, 1, 0)>(vb), h1 = tr_read<v_rd_off(D0, 1, 1)>(vb);
  const s16x4 l2 = tr_read<v_rd_off(D0, 2, 0)>(vb), h2 = tr_read<v_rd_off(D0, 2, 1)>(vb), l3 = tr_read<v_rd_off(D0, 3, 0)>(vb), h3 = tr_read<v_rd_off(D0, 3, 1)>(vb);
  asm volatile("s_waitcnt lgkmcnt(0)" ::: "memory"); SBAR();
#define PK(L, H) (bf16x8){L[0], L[1], L[2], L[3], H[0], H[1], H[2], H[3]}
  od = __builtin_amdgcn_mfma_f32_32x32x16_bf16(pa0, PK(l0, h0), od, 0, 0, 0);
  od = __builtin_amdgcn_mfma_f32_32x32x16_bf16(pa1, PK(l1, h1), od, 0, 0, 0);
  od = __builtin_amdgcn_mfma_f32_32x32x16_bf16(pa2, PK(l2, h2), od, 0, 0, 0);
  od = __builtin_amdgcn_mfma_f32_32x32x16_bf16(pa3, PK(l3, h3), od, 0, 0, 0);
#undef PK
}
__device__ __forceinline__ void pv_d0(f32x16* o, int vb, bf16x8 pa0, bf16x8 pa1, bf16x8 pa2, bf16x8 pa3) {
  pv_one<0>(o[0], vb, pa0, pa1, pa2, pa3); pv_one<1>(o[1], vb, pa0, pa1, pa2, pa3); pv_one<2>(o[2], vb, pa0, pa1, pa2, pa3); pv_one<3>(o[3], vb, pa0, pa1, pa2, pa3);
}
__device__ __forceinline__ void na_mask(f32x16& p0, f32x16& p1, int kr, int qr_, int rs, int qc, int cs, int hi, const float* bias) {
  const float NEG = -1e30f;
  if (kr < rs || kr >= rs + 8) {
#pragma unroll
    for (int i = 0; i < 16; ++i) { p0[i] = NEG; p1[i] = NEG; }
    return;
  }
  const float* bp = bias + (kr - qr_ + 7) * 128 + (4 * hi - qc + 63);
  const int e = 4 * hi - cs;
#pragma unroll
  for (int i = 0; i < 16; ++i) {
    const int ci = (i & 3) + 8 * (i >> 2);
    const float b0 = bp[ci], b1 = bp[ci + 32];
    p0[i] = ((unsigned)(ci + e) < 16u) ? p0[i] + b0 : NEG;
    p1[i] = ((unsigned)(ci + 32 + e) < 16u) ? p1[i] + b1 : NEG;
  }
}

template <bool NA, int LD, int LDO>
__device__ __forceinline__ void attn_body(const bf16_t* __restrict__ Qb, const bf16_t* __restrict__ Kh, const bf16_t* __restrict__ Vh,
                                          bf16_t* __restrict__ Ob, int NT, char* lds, int r0, int kr0, const float* bias, int wave_s) {
  const int tid = tid_fresh(wave_s), wid = __builtin_amdgcn_readfirstlane(tid >> 6), lane = tid & 63, r32 = lane & 31, hi = lane >> 5;
  bf16_t* V_lds = (bf16_t*)lds; bf16_t* K_lds = (bf16_t*)(lds + 2 * SHM_V);
  float* ws = (float*)(lds + 2 * SHM_V + 2 * SHM_K) + wid * 64; float* li_l = ws; float* al_l = ws + 32;
  float m_reg = NA ? -3e4f : -1e30f, l_reg = 0; f32x16 o[4] = {}; bf16x8 qr[8];
  const int qrow = r0 + (wid >> 1), rs = min(max(qrow - 4, 0), GRID_R - 8), qc = 32 * (wid & 1) + r32, cs = min(max(qc - 8, 0), GRID_W - 16);
  const bf16_t* Qw = Qb + (long)(wid * QBLK + r32) * LD + hi * 8;
#pragma unroll
  for (int d0 = 0; d0 < 8; ++d0) qr[d0] = *reinterpret_cast<const bf16x8*>(Qw + d0 * 16);
  const int sr = tid >> 4, sc = (tid & 15) * 8, vst0 = v_st(sr, sc), vst1 = v_st(32 + sr, sc);
  const int vb0 = (int)(uintptr_t)V_lds + v_rd_base(lane);
  constexpr int SD = NA ? 1 : 2;
  struct { bf16x8 vs0, vs1, ks0, ks1; } sr_[SD];
#define SLOAD(i, k0) do { sr_[i].vs0 = *reinterpret_cast<const bf16x8*>(&Vh[(long)((k0) + sr) * LD + sc]); sr_[i].vs1 = *reinterpret_cast<const bf16x8*>(&Vh[(long)((k0) + 32 + sr) * LD + sc]); \
    sr_[i].ks0 = *reinterpret_cast<const bf16x8*>(&Kh[(long)((k0) + sr) * LD + sc]); sr_[i].ks1 = *reinterpret_cast<const bf16x8*>(&Kh[(long)((k0) + 32 + sr) * LD + sc]); } while (0)
#define SWRITE(b, i) do { *(bf16x8*)((char*)V_lds + (b) * SHM_V + vst0) = sr_[i].vs0;          \
    *(bf16x8*)((char*)V_lds + (b) * SHM_V + vst1) = sr_[i].vs1; int kc = sc * 2;               \
    *(bf16x8*)((char*)K_lds + (b) * SHM_K + KSWZ(sr, kc)) = sr_[i].ks0;                       \
    *(bf16x8*)((char*)K_lds + (b) * SHM_K + KSWZ(32 + sr, kc)) = sr_[i].ks1; } while (0)
#define SWAIT() do { if constexpr (SD == 2) asm volatile("s_waitcnt vmcnt(4)" ::: "memory"); else asm volatile("s_waitcnt vmcnt(0)" ::: "memory"); } while (0)
#define RESC(a) do { if (__any((a) < 1.f)) { if (hi == 0) al_l[r32] = (a); asm volatile("s_waitcnt lgkmcnt(0)" ::: "memory"); \
    _Pragma("unroll") for (int d = 0; d < 4; ++d) _Pragma("unroll") for (int r = 0; r < 16; ++r) o[d][r] *= al_l[crow(r, hi)]; } } while (0)
#define NAM(P0, P1, j) do { if constexpr (NA) na_mask(P0, P1, kr0 + (j), qrow, rs, qc, cs, hi, bias); } while (0)
  f32x16 pA0, pA1, pB0, pB1; float mnA, mnB, alA, alB; bf16x8 pa0, pa1, pa2, pa3;
  constexpr int SE = 0, SO = SD - 1;
#define VALID(j) (!NA || (kr0 + (j) >= rs && kr0 + (j) < rs + 8))
  bool vA, vB;
  SLOAD(SE, 0); asm volatile("s_waitcnt vmcnt(0)" ::: "memory"); SWRITE(0, SE); __syncthreads();
  vA = VALID(0); alA = 1.f;
  if (vA) { qkt(pA0, pA1, K_lds, qr, r32, hi); NAM(pA0, pA1, 0); partialSM(pA0, pA1, m_reg, mnA, alA); }
  SLOAD(SO, KVBLK); if constexpr (SD == 2) { if (2 < NT) SLOAD(SE, 2 * KVBLK); }
  SWAIT(); SWRITE(1, SO); __syncthreads();
  for (int j = 1; j + 1 < NT; j += 2) {
    vB = VALID(j); alB = 1.f;
    SBAR(); if (vB) qkt(pB0, pB1, (bf16_t*)((char*)K_lds + SHM_K), qr, r32, hi);
    SLOAD(SO, (j + SD) * KVBLK); SBAR();
    if (vA) { finishSM(pA0, pA1, alA, l_reg, pa0, pa1, pa2, pa3); SBAR(); pv_d0(o, vb0, pa0, pa1, pa2, pa3); }
    if (vB) { NAM(pB0, pB1, j); partialSM(pB0, pB1, m_reg, mnB, alB); }
    __syncthreads(); SWAIT(); SWRITE(0, SE);
    RESC(alB); __syncthreads();
    vA = VALID(j + 1); alA = 1.f;
    SBAR(); if (vA) qkt(pA0, pA1, K_lds, qr, r32, hi);
    if (SD == 1 || j + 3 < NT) SLOAD(SE, (j + 1 + SD) * KVBLK); SBAR();
    if (vB) { finishSM(pB0, pB1, alB, l_reg, pa0, pa1, pa2, pa3); SBAR(); pv_d0(o, vb0 + (int)SHM_V, pa0, pa1, pa2, pa3); }
    if (vA) { NAM(pA0, pA1, j + 1); partialSM(pA0, pA1, m_reg, mnA, alA); }
    __syncthreads(); SWAIT(); SWRITE(1, SO);
    RESC(alA); __syncthreads();
  }
  vB = VALID(NT - 1); alB = 1.f;
  SBAR(); if (vB) qkt(pB0, pB1, (bf16_t*)((char*)K_lds + SHM_K), qr, r32, hi);
  if (vA) { finishSM(pA0, pA1, alA, l_reg, pa0, pa1, pa2, pa3); SBAR(); pv_d0(o, vb0, pa0, pa1, pa2, pa3); }
  if (vB) { NAM(pB0, pB1, NT - 1); partialSM(pB0, pB1, m_reg, mnB, alB); }
  __syncthreads(); RESC(alB);
  if (vB) { finishSM(pB0, pB1, alB, l_reg, pa0, pa1, pa2, pa3); SBAR();
    pv_d0(o, vb0 + (int)SHM_V, pa0, pa1, pa2, pa3); }
#undef VALID
  if (hi == 0) li_l[r32] = l_reg; asm volatile("s_waitcnt lgkmcnt(0)" ::: "memory");
  float rli[16];
#pragma unroll
  for (int r = 0; r < 16; ++r) rli[r] = __builtin_amdgcn_rcpf(li_l[crow(r, hi)]);
  bf16_t* Ow = Ob + (long)(wid * QBLK) * LDO;
  {
    bf16_t* stg = (bf16_t*)(lds + SHM_OST) + wid * 4096;
#pragma unroll
    for (int r = 0; r < 16; ++r) { const int orow = crow(r, hi);
#pragma unroll
      for (int d0 = 0; d0 < 4; ++d0) stg[orow * 128 + d0 * 32 + r32] = (bf16_t)(cvtpk(o[d0][r] * rli[r], 0.f) & 0xffffu); }
    asm volatile("s_waitcnt lgkmcnt(0)" ::: "memory");
#pragma unroll
    for (int i = 0; i < 8; ++i) { const int row = i * 4 + (lane >> 4), ch = lane & 15; const u32x4 v = *(const u32x4*)(stg + row * 128 + ch * 8); *(u32x4*)(Ow + (long)row * LDO + ch * 8) = v; }
  }
  __syncthreads();
#undef SLOAD
#undef SWRITE
#undef SWAIT
#undef RESC
#undef NAM
}
#undef SBAR
}

struct Params {
    const float* x; const float* mix_norm; const float* ffn_norm; const float* final_norm;
    const float* na_w_qkv; const float* na_rpb; const float* na_w_o;
    const float* sc_w_in; const float* sc_conv_w; const float* sc_w_out;
    const float* gqa_w_qkv; const float* gqa_q_norm; const float* gqa_k_norm; const float* gqa_w_o;
    const float* ffn_w_up; const float* ffn_conv_w; const float* ffn_conv_b; const float* ffn_w_down;
    float* out; unsigned char* ws;
};

constexpr int NTHREADS = 512, NWAVES = 8;
constexpr int CTLW_OFF = RTAB_OFF + 11 * 1024;
constexpr int LDS_BYTES = CTLW_OFF + 1024;

__device__ __forceinline__ void transpose_item(const float* __restrict__ W, const float* __restrict__ gain, int K, int N, bf16_t* __restrict__ WT, LAS float* scr, int item, int lane) {
    const int nblk = N / 32, kb = item / nblk, nb = item % nblk, k0 = 64 * kb, n0 = 32 * nb;
#pragma unroll 8
    for (int i = 0; i < 32; ++i) { const int kk = 2 * i + (lane >> 5); scr[kk * 33 + (lane & 31)] = W[(size_t)(k0 + kk) * N + n0 + (lane & 31)]; }
    asm volatile("s_waitcnt lgkmcnt(0)" ::: "memory");
    const int c = lane & 7;
    f32x4 g0 = {1.f, 1.f, 1.f, 1.f}, g1 = {1.f, 1.f, 1.f, 1.f};
    if (gain) { g0 = *(const f32x4*)(gain + k0 + 8 * c); g1 = *(const f32x4*)(gain + k0 + 8 * c + 4); }
#pragma unroll
    for (int j = 0; j < 4; ++j) { const int n = (lane >> 3) + 8 * j; const LAS float* s = scr + (8 * c) * 33 + n;
        u32x4 o; o.x = cvt_pk_bf16(s[0 * 33] * g0.x, s[1 * 33] * g0.y); o.y = cvt_pk_bf16(s[2 * 33] * g0.z, s[3 * 33] * g0.w); o.z = cvt_pk_bf16(s[4 * 33] * g1.x, s[5 * 33] * g1.y); o.w = cvt_pk_bf16(s[6 * 33] * g1.z, s[7 * 33] * g1.w);
        *(u32x4*)(WT + (size_t)(n0 + n) * K + k0 + 8 * c) = o; }
    asm volatile("s_waitcnt lgkmcnt(0)" ::: "memory");
}
__device__ __forceinline__ void convert_matrix(const float* W, const float* gain, int K, int N, bf16_t* WT, LAS float* scr, int gw, int ngw, int lane) {
    const int items = (K / 64) * (N / 32);
    for (int it = gw; it < items; it += ngw) transpose_item(W, gain, K, N, WT, scr, it, lane);
}
__device__ __forceinline__ void unpack8(const u32x4 w, float* f);
__device__ __forceinline__ void x_prep_rows(const float* X, bf16_t* XH, float* rstd, int gw, int ngw, int lane) {
    for (int m = gw; m < MT; m += ngw) {
        const f32x4* xr = (const f32x4*)(X + (size_t)m * DM) + lane;
        f32x4 v[8]; float s = 0.f;
#pragma unroll
        for (int j = 0; j < 8; ++j) { v[j] = xr[64 * j]; s += (v[j].x * v[j].x + v[j].y * v[j].y) + (v[j].z * v[j].z + v[j].w * v[j].w); }
        s = wave_sum(s);
        if (lane == 0) rstd[m] = rsqrtf(s * (1.f / DM) + EPS);
        u32x2* h8 = (u32x2*)(XH + (size_t)m * DM) + lane;
#pragma unroll
        for (int j = 0; j < 8; ++j) { u32x2 w; w.x = cvt_pk_bf16(v[j].x, v[j].y); w.y = cvt_pk_bf16(v[j].z, v[j].w); h8[64 * j] = w; }
    }
}
__device__ __forceinline__ void rstd_pass(const float* Pg, float* rstdg, int gtid, int gthreads, int tok0) {
    const float* P = Pg + tok0; float* rstd = rstdg + tok0;
    for (int r = gtid >> 3; r < SEQ; r += gthreads >> 3) {
        const int part = gtid & 7; float sq = 0.f;
#pragma unroll
        for (int i = 0; i < 4; ++i) sq += P[(size_t)(part * 4 + i) * MT + r];
        sq += shx<1>(sq); sq += shx<2>(sq); sq += shx<4>(sq);
        if (part == 0) rstd[r] = rsqrtf(sq * (1.f / DM) + EPS);
    }
}
__device__ __forceinline__ void rmsnorm_rows_f32(const bf16_t* Xg, const float* __restrict__ g, float* Og, int gw, int ngw, int lane, int tok0) {
    const bf16_t* X = Xg + (size_t)tok0 * DM; float* O = Og + (size_t)tok0 * DM;
    for (int m = gw; m < SEQ; m += ngw) {
        const u32x4* xr = (const u32x4*)(X + (size_t)m * DM) + lane;
        float v[4][8]; float s = 0.f;
#pragma unroll
        for (int j = 0; j < 4; ++j) { unpack8(xr[64 * j], v[j]);
#pragma unroll
            for (int e = 0; e < 8; ++e) s += v[j][e] * v[j][e]; }
        const float rstd = rsqrtf(wave_sum(s) * (1.f / DM) + EPS);
        float* o = O + (size_t)m * DM;
#pragma unroll
        for (int j = 0; j < 4; ++j) { const f32x4 g0 = *(const f32x4*)(g + 512 * j + 8 * lane), g1 = *(const f32x4*)(g + 512 * j + 8 * lane + 4);
            *(f32x4*)(o + 512 * j + 8 * lane) = (f32x4){v[j][0] * rstd * g0.x, v[j][1] * rstd * g0.y, v[j][2] * rstd * g0.z, v[j][3] * rstd * g0.w};
            *(f32x4*)(o + 512 * j + 8 * lane + 4) = (f32x4){v[j][4] * rstd * g1.x, v[j][5] * rstd * g1.y, v[j][6] * rstd * g1.z, v[j][7] * rstd * g1.w}; }
    }
}

__device__ __forceinline__ void unpack8(const u32x4 w, float* f) {
    f[0] = bf_lo(w.x); f[1] = bf_hi(w.x); f[2] = bf_lo(w.y); f[3] = bf_hi(w.y); f[4] = bf_lo(w.z); f[5] = bf_hi(w.z); f[6] = bf_lo(w.w); f[7] = bf_hi(w.w);
}
__device__ __forceinline__ u32x4 pack8(const float* f) {
    u32x4 w; w.x = cvt_pk_bf16(f[0], f[1]); w.y = cvt_pk_bf16(f[2], f[3]); w.z = cvt_pk_bf16(f[4], f[5]); w.w = cvt_pk_bf16(f[6], f[7]); return w;
}

__device__ __forceinline__ void sc_conv_phase(const bf16_t* U, const float* __restrict__ cw, bf16_t* Y, int gtid, int gthreads, int tok0) {
    constexpr int CH = 16, R = 8, NG = DM / 8, NITEM = (SEQ / CH) * NG;
    const u32x4 zero = {0u, 0u, 0u, 0u};
    for (int it = gtid; it < NITEM; it += gthreads) {
        const int c8 = it % NG, t0 = tok0 + (it / NG) * CH, col = c8 * 8;
        float w0[8], w1[8], w2[8];
#pragma unroll
        for (int e = 0; e < 8; e += 4) { *(f32x4*)(w0 + e) = *(const f32x4*)(cw + col + e); *(f32x4*)(w1 + e) = *(const f32x4*)(cw + DM + col + e); *(f32x4*)(w2 + e) = *(const f32x4*)(cw + 2 * DM + col + e); }
        float zp[8], zc[8];
        {
            const bf16_t* r = U + (size_t)(t0 - 1) * NA_N + col;
            u32x4 pa = zero, pb = zero;
            if ((t0 % SEQ) != 0) { pa = *(const u32x4*)(r + DM); pb = *(const u32x4*)(r + 2 * DM); }
            const u32x4 ca = *(const u32x4*)(r + NA_N + DM), cb = *(const u32x4*)(r + NA_N + 2 * DM);
            float a[8], b[8]; unpack8(pa, a); unpack8(pb, b);
#pragma unroll
            for (int e = 0; e < 8; ++e) zp[e] = a[e] * b[e];
            unpack8(ca, a); unpack8(cb, b);
#pragma unroll
            for (int e = 0; e < 8; ++e) zc[e] = a[e] * b[e];
        }
        for (int k = 0; k < CH / R; ++k) {
            u32x4 na[R], nb[R], gbv[R];
#pragma unroll
            for (int r_ = 0; r_ < R; ++r_) { const int t = t0 + k * R + r_; const bf16_t* r = U + (size_t)t * NA_N + col;
                gbv[r_] = *(const u32x4*)r;
                if (((t + 1) % SEQ) != 0) { na[r_] = *(const u32x4*)(r + NA_N + DM); nb[r_] = *(const u32x4*)(r + NA_N + 2 * DM); } else { na[r_] = zero; nb[r_] = zero; } }
#pragma unroll
            for (int r_ = 0; r_ < R; ++r_) { const int t = t0 + k * R + r_;
                float a[8], b[8], zn[8], gb[8], y[8]; unpack8(na[r_], a); unpack8(nb[r_], b); unpack8(gbv[r_], gb);
#pragma unroll
                for (int e = 0; e < 8; ++e) zn[e] = a[e] * b[e];
#pragma unroll
                for (int e = 0; e < 8; ++e) y[e] = gb[e] * (w0[e] * zp[e] + w1[e] * zc[e] + w2[e] * zn[e]);
                *(u32x4*)(Y + (size_t)t * DM + col) = pack8(y);
#pragma unroll
                for (int e = 0; e < 8; ++e) { zp[e] = zc[e]; zc[e] = zn[e]; } }
        }
    }
}

__device__ __forceinline__ void glu_fix_phase(const bf16_t* RAW, const float* __restrict__ cw, const float* __restrict__ cb, bf16_t* ACT, int gtid, int gthreads, int blk0) {
    constexpr int NG = DFF / 8, NITEM = (SEQ / 64) * 2 * NG;
    const u32x4 zero = {0u, 0u, 0u, 0u};
    for (int it = gtid; it < NITEM; it += gthreads) {
        const int c8 = it % NG, rest = it / NG, which = rest & 1, blk = blk0 + (rest >> 1), col = c8 * 8;
        const int t = 64 * blk + (which ? 63 : 0);
        const bf16_t* rc = RAW + ((size_t)blk * 4 + (which ? 3 : 0)) * UP_N + col;
        const bf16_t* rp = which ? rc - UP_N : rc - UP_N;
        const bf16_t* rn = which ? rc + UP_N : rc + UP_N;
        const bool has_p = which ? true : (t % SEQ) != 0, has_n = which ? ((t + 1) % SEQ) != 0 : true;
        u32x4 gp = zero, up = zero, gn = zero, un = zero;
        if (has_p) { gp = *(const u32x4*)rp; up = *(const u32x4*)(rp + DFF); }
        if (has_n) { gn = *(const u32x4*)rn; un = *(const u32x4*)(rn + DFF); }
        const u32x4 gc = *(const u32x4*)rc, uc = *(const u32x4*)(rc + DFF);
        float a[8], b[8], c[8], y[8], w0[8], w1[8], w2[8], bb[8], hg[8];
#pragma unroll
        for (int e = 0; e < 8; e += 4) { *(f32x4*)(w0 + e) = *(const f32x4*)(cw + col + e); *(f32x4*)(w1 + e) = *(const f32x4*)(cw + UP_N + col + e); *(f32x4*)(w2 + e) = *(const f32x4*)(cw + 2 * UP_N + col + e); *(f32x4*)(bb + e) = *(const f32x4*)(cb + col + e); }
        unpack8(gp, a); unpack8(gc, b); unpack8(gn, c);
#pragma unroll
        for (int e = 0; e < 8; ++e) hg[e] = w0[e] * a[e] + w1[e] * b[e] + w2[e] * c[e] + bb[e];
#pragma unroll
        for (int e = 0; e < 8; e += 4) { *(f32x4*)(w0 + e) = *(const f32x4*)(cw + DFF + col + e); *(f32x4*)(w1 + e) = *(const f32x4*)(cw + UP_N + DFF + col + e); *(f32x4*)(w2 + e) = *(const f32x4*)(cw + 2 * UP_N + DFF + col + e); *(f32x4*)(bb + e) = *(const f32x4*)(cb + DFF + col + e); }
        unpack8(up, a); unpack8(uc, b); unpack8(un, c);
#pragma unroll
        for (int e = 0; e < 8; ++e) { const float hu = w0[e] * a[e] + w1[e] * b[e] + w2[e] * c[e] + bb[e];
            const float sg = __builtin_amdgcn_rcpf(1.f + __builtin_amdgcn_exp2f(-1.4426950408889634f * hg[e])); y[e] = hg[e] * sg * hu; }
        *(u32x4*)(ACT + (size_t)t * DFF + col) = pack8(y);
    }
}

__device__ __forceinline__ void gqa_prep_phase(bf16_t* QKVg, const float* __restrict__ qn, const float* __restrict__ kn, int gw, int ngw, int lane, int tok0) {
    bf16_t* QKV = QKVg + (size_t)tok0 * GQ_N;
    const int sub = lane & 15, q4 = lane >> 4, sec = sub >> 3, half = (sub >> 2) & 1, i0 = 8 * (sub & 3);
    float inv[8], gq[8], gk[8], gqp[8], gkp[8];
#pragma unroll
    for (int j = 0; j < 8; ++j) { inv[j] = __builtin_amdgcn_exp2f(-(float)(i0 + j) * (13.287712379549449f / 32.f)) * 0.15915494309189535f;
        gq[j] = qn[8 * sub + j]; gqp[j] = qn[8 * (sub ^ 4) + j]; gk[j] = kn[8 * sub + j]; gkp[j] = kn[8 * (sub ^ 4) + j]; }
    const float sgn = half ? 1.f : -1.f;
    constexpr int NSTEP = SEQ * 20 / 4;
    int st = gw;
    u32x4 raw = {0u, 0u, 0u, 0u};
    if (st < NSTEP) { const int it = st * 4 + q4; raw = *(const u32x4*)(QKV + (size_t)(it / 20) * GQ_N + (it % 20) * HD + 8 * sub); }
    for (; st < NSTEP; st += ngw) {
        const int it = st * 4 + q4, t = it / 20, hh = it % 20;
        bf16_t* p = QKV + (size_t)t * GQ_N + hh * HD + 8 * sub;
        u32x4 nraw = {0u, 0u, 0u, 0u};
        if (st + ngw < NSTEP) { const int it2 = (st + ngw) * 4 + q4; nraw = *(const u32x4*)(QKV + (size_t)(it2 / 20) * GQ_N + (it2 % 20) * HD + 8 * sub); }
        float x[8], xp[8], o[8]; unpack8(raw, x);
        u32x4 praw; praw.x = shxu<4>(raw.x); praw.y = shxu<4>(raw.y); praw.z = shxu<4>(raw.z); praw.w = shxu<4>(raw.w);
        unpack8(praw, xp);
        float ss = 0.f;
#pragma unroll
        for (int j = 0; j < 8; ++j) ss += x[j] * x[j];
        ss += shx<1>(ss); ss += shx<2>(ss); ss += shx<4>(ss); ss += shx<8>(ss);
        const float rstd = rsqrtf(ss * (1.f / HD) + EPS);
        const int pos = t % SEQ; const float pf = (float)(sec == 0 ? pos / GRID_W : pos % GRID_W);
        const bool isq = hh < 16;
#pragma unroll
        for (int j = 0; j < 8; ++j) { const float y = x[j] * rstd * (isq ? gq[j] : gk[j]), yp = xp[j] * rstd * (isq ? gqp[j] : gkp[j]);
            const float rev = pf * inv[j]; const float sn = __builtin_amdgcn_sinf(rev), cs = __builtin_amdgcn_cosf(rev);
            o[j] = y * cs + sgn * yp * sn; }
        *(u32x4*)p = pack8(o);
        raw = nraw;
    }
}

#define XB_TMO      128
#define XB_XCNT(j)  (256  + 64 * (j))
#define XB_XSUB(j)  (1280 + 64 * (j))
#define XB_XGEN(j)  (2304 + 64 * (j))
#define XB_TOP      3328
#define XB_TOPGEN   3392
#define XCD_BAR_WORDS 3456
#define XB_SPIN_CAP (1u << 20)
__device__ __forceinline__ unsigned xb_ld(unsigned* p)              { return __hip_atomic_load(p, __ATOMIC_RELAXED, __HIP_MEMORY_SCOPE_AGENT); }
__device__ __forceinline__ unsigned xb_add(unsigned* p, unsigned v) { return __hip_atomic_fetch_add(p, v, __ATOMIC_RELAXED, __HIP_MEMORY_SCOPE_AGENT); }
__device__ __forceinline__ unsigned xb_xcc_id() { return (unsigned)__builtin_amdgcn_s_getreg((3 << 11) | 20) & 0xFu; }
#define XB_SPIN(cond, bar) do { unsigned _sp = 0; while (cond) { __builtin_amdgcn_s_sleep(1); \
    if ((++_sp & 255u) == 0u) { if (xb_ld(&(bar)[XB_TMO])) break; if (_sp > XB_SPIN_CAP) { atomicAdd(&(bar)[XB_TMO], 1u); break; } } } } while (0)
struct XcdBarrier { unsigned* bar; unsigned x; volatile LAS unsigned* st; };
__device__ __forceinline__ XcdBarrier xcd_barrier_post(unsigned* bar, volatile LAS unsigned* st) {
    XcdBarrier b; b.bar = bar; b.x = xb_xcc_id(); b.st = st;
    if (threadIdx.x == 0) (void)xb_add(&bar[XB_XCNT(b.x)], 1u);
    return b;
}
__device__ __forceinline__ void xcd_barrier_complete(unsigned* bar, unsigned x, unsigned& nloc, unsigned& nx) {
    const unsigned G = 256u;
    unsigned sum, cnt, mine, sp = 0u;
    for (;;) {
        sum = 0u; cnt = 0u; mine = 0u;
#pragma unroll
        for (unsigned j = 0; j < 16; ++j) { const unsigned c = xb_ld(&bar[XB_XCNT(j)]); sum += c; cnt += (c > 0u) ? 1u : 0u; mine = (j == x) ? c : mine; }
        if (sum == G) break;
        __builtin_amdgcn_s_sleep(1);
        if ((++sp & 255u) == 0u) { if (xb_ld(&bar[XB_TMO])) break; if (sp > XB_SPIN_CAP) { atomicAdd(&bar[XB_TMO], 1u); break; } }
    }
    nloc = mine > 0u ? mine : 1u; nx = cnt > 0u ? cnt : 1u;
}
__device__ __forceinline__ void xcd_barrier(const XcdBarrier& b, bool t0) {
    asm volatile("s_waitcnt vmcnt(0)" ::: "memory");
    __syncthreads();
    if (t0) {
        unsigned* bar = b.bar;
        __builtin_amdgcn_s_waitcnt(0);
        unsigned nloc = b.st[0], nx = b.st[1];
        if (nloc == 0u) { xcd_barrier_complete(bar, b.x, nloc, nx); b.st[0] = nloc; b.st[1] = nx; }
        const unsigned old = xb_add(&bar[XB_XSUB(b.x)], 1u);
        const unsigned gen = old / nloc;
        if (old + 1u == (gen + 1u) * nloc) {
            __builtin_amdgcn_fence(__ATOMIC_RELEASE, "agent");
            asm volatile("s_waitcnt vmcnt(0)" ::: "memory");
            const unsigned og = xb_add(&bar[XB_TOP], 1u);
            const unsigned tg = og / nx;
            if (og + 1u == (tg + 1u) * nx) xb_add(&bar[XB_TOPGEN], 1u);
            else XB_SPIN(xb_ld(&bar[XB_TOPGEN]) == tg, bar);
            __builtin_amdgcn_fence(__ATOMIC_ACQUIRE, "agent");
            xb_add(&bar[XB_XGEN(b.x)], 1u);
            asm volatile("s_waitcnt vmcnt(0)" ::: "memory");
        } else {
            XB_SPIN(xb_ld(&bar[XB_XGEN(b.x)]) == gen, bar);
            __builtin_amdgcn_fence(__ATOMIC_ACQUIRE, "agent");
            asm volatile("s_waitcnt vmcnt(0)" ::: "memory");
        }
    }
    __syncthreads();
}

__device__ __forceinline__ void xcc_local_barrier(unsigned* bar, unsigned x, unsigned nloc, bool t0) {
    asm volatile("s_waitcnt vmcnt(0)" ::: "memory");
    __syncthreads();
    if (t0) {
        __builtin_amdgcn_s_waitcnt(0);
        const unsigned old = xb_add(&bar[XB_XSUB(x)], 1u);
        const unsigned gen = old / nloc;
        if (old + 1u == (gen + 1u) * nloc) xb_add(&bar[XB_XGEN(x)], 1u);
        else XB_SPIN(xb_ld(&bar[XB_XGEN(x)]) == gen, bar);
        __builtin_amdgcn_fence(__ATOMIC_ACQUIRE, "agent");
        asm volatile("s_waitcnt vmcnt(0)" ::: "memory");
    }
    __syncthreads();
}

__device__ __forceinline__ int ctlw_read(LAS unsigned char* ldsl, int idx) { int off = CTLW_OFF + 4 * idx; asm volatile("" : "+v"(off)); return __builtin_amdgcn_readfirstlane((int)*(volatile LAS unsigned*)(ldsl + off)); }

typedef const __attribute__((address_space(4))) Params* CParams;
__device__ __forceinline__ CParams kp() { CParams q = (CParams)__builtin_amdgcn_kernarg_segment_ptr(); asm volatile("" : "+s"(q)); return q; }
#define LANE_ (tid_fresh(wave_s) & 63)
#define WAVE_ (wave_s)
#define GW_ ((int)blockIdx.x * NWAVES + WAVE_)
#define NGW_ (256 * NWAVES)
#define GTID_ ((int)blockIdx.x * NTHREADS + tid_fresh(wave_s))
#define GTHR_ (256 * NTHREADS)
#define CTLW_ ((volatile LAS unsigned*)(ldsl + CTLW_OFF))
#define VX_ ctlw_read(ldsl, 2)
#define VR_ ctlw_read(ldsl, 3)
#define LGW_ (VR_ * NWAVES + WAVE_)
#define LNGW_ (32 * NWAVES)
#define LGTID_ (VR_ * NTHREADS + tid_fresh(wave_s))
#define LGTHR_ (32 * NTHREADS)
#define TOK0_ (VX_ * SEQ)
#define ACTM_ ((bf16_t*)(kp()->ws + WS_ACT) + (size_t)VX_ * SEQ * (DFF - DM))
#define BIGG_ ((bf16_t*)(kp()->ws + WS_BIG) + (size_t)VX_ * SEQ * (NA_N - GQ_N))

__global__ void __launch_bounds__(NTHREADS, 2) fwd_megakernel(Params p_unused) {
    extern __shared__ __attribute__((aligned(16))) unsigned char lds[];
    cg::grid_group grid = cg::this_grid();
    LAS unsigned char* ldsl = (LAS unsigned char*)lds;
    constexpr int G = 256;
    const int wave_s = __builtin_amdgcn_readfirstlane(threadIdx.x >> 6);
    if (threadIdx.x < 8) ((volatile LAS unsigned*)(ldsl + CTLW_OFF))[threadIdx.x] = 0u;
    __syncthreads();
    if (threadIdx.x == 0) {
        unsigned* bar = (unsigned*)(kp()->ws + WS_CTL); const unsigned x = xb_xcc_id();
        const unsigned rank = xb_add(&bar[XB_XCNT(x)], 1u);
        CTLW_[2] = x; CTLW_[3] = rank;
    }
#define XBAR() do { if (ctlw_read(ldsl, 4) != 0) xcc_local_barrier((unsigned*)(kp()->ws + WS_CTL), (unsigned)VX_, 32u, tid_fresh(wave_s) == 0); \
    else { XcdBarrier xb_; xb_.bar = (unsigned*)(kp()->ws + WS_CTL); xb_.x = xb_xcc_id(); xb_.st = (volatile LAS unsigned*)(ldsl + CTLW_OFF); xcd_barrier(xb_, tid_fresh(wave_s) == 0); } } while (0)

    x_prep_rows(kp()->x, (bf16_t*)(kp()->ws + WS_XH), (float*)(kp()->ws + WS_RSTD), GW_, NGW_, LANE_);
#define GBAR() do { XcdBarrier xb_; xb_.bar = (unsigned*)(kp()->ws + WS_CTL); xb_.x = xb_xcc_id(); xb_.st = (volatile LAS unsigned*)(ldsl + CTLW_OFF); xcd_barrier(xb_, tid_fresh(wave_s) == 0); } while (0)

    for (int layer = 0; layer < DEPTH; ++layer) {
        const int mixer = layer % 3, j = layer / 3;
        {
            LAS float* scr = (LAS float*)(ldsl + WAVE_ * 8704);
            unsigned char* ws = kp()->ws;
            const float* w_in = mixer == 0 ? kp()->na_w_qkv + (size_t)j * DM * NA_N : mixer == 1 ? kp()->sc_w_in : kp()->gqa_w_qkv;
            const float* w_o = mixer == 0 ? kp()->na_w_o + (size_t)j * DM * DM : mixer == 1 ? kp()->sc_w_out : kp()->gqa_w_o;
            bf16_t* d_in_ = mixer == 0 ? (bf16_t*)(ws + WS_NAQKV + j * SZ_W6144) : mixer == 1 ? (bf16_t*)(ws + WS_SCIN) : (bf16_t*)(ws + WS_GQKV);
            bf16_t* d_o_ = mixer == 0 ? (bf16_t*)(ws + WS_NAO + j * SZ_W2048) : mixer == 1 ? (bf16_t*)(ws + WS_SCOUT) : (bf16_t*)(ws + WS_GO);
            convert_matrix(w_in, kp()->mix_norm + layer * DM, DM, mixer == 2 ? GQ_N : NA_N, d_in_, scr, GW_, NGW_, LANE_);
            convert_matrix(w_o, nullptr, DM, DM, d_o_, scr, GW_, NGW_, LANE_);
            convert_matrix(kp()->ffn_w_up + (size_t)layer * DM * UP_N, kp()->ffn_norm + layer * DM, DM, UP_N, (bf16_t*)(ws + WS_UP + layer * SZ_WUP), scr, GW_, NGW_, LANE_);
            convert_matrix(kp()->ffn_w_down + (size_t)layer * DFF * DM, nullptr, DFF, DM, (bf16_t*)(ws + WS_DN + layer * SZ_WDN), scr, GW_, NGW_, LANE_);
        }
        if (kp()->ws == nullptr) grid.sync();
        GBAR();
        if (layer == 0) {
            if (tid_fresh(wave_s) == 0) { unsigned* bar = (unsigned*)(kp()->ws + WS_CTL); bool ok = true;
                for (unsigned jj = 0; jj < 16; ++jj) ok = ok && (xb_ld(&bar[XB_XCNT(jj)]) == (jj < 8 ? 32u : 0u));
                unsigned bx_ = blockIdx.x; asm volatile("" : "+s"(bx_));
                if (ok) CTLW_[4] = 1u; else { CTLW_[2] = bx_ % 8u; CTLW_[3] = bx_ / 8u; CTLW_[4] = 0u; } }
            __syncthreads();
        }
        {
            unsigned char* ws = kp()->ws;
            const bf16_t* Wt = mixer == 0 ? (const bf16_t*)(ws + WS_NAQKV + j * SZ_W6144) : mixer == 1 ? (const bf16_t*)(ws + WS_SCIN) : (const bf16_t*)(ws + WS_GQKV);
            const int N = mixer == 2 ? GQ_N : NA_N;
            pg8::Gemm g{(const bf16_t*)(ws + WS_XH), Wt, MT, N, DM, (size_t)256 * DM * 2, (size_t)128 * DM * 2}; pg8::StaticOrder S; S.init(N, VX_, VR_);
            pg8::EpiBf16 E{mixer == 2 ? BIGG_ : (bf16_t*)(ws + WS_BIG), N, (const float*)(ws + WS_RSTD) + (size_t)(2 * layer) * MT};
            pg8::gemm_phase<pg8::EpiBf16>(ldsl, g, S, E, wave_s);
        }
        XBAR();
        if (mixer == 0) {
            for (int i = 0; i < 4; ++i) {
                const int v = VR_, rg = 2 * i + (v & 1), b = VX_, h = v >> 1;
                const int r0 = 4 * rg, kr0 = min(max(r0 - 4, 0), GRID_R - 8), klast = min(max(r0 - 1, 0), GRID_R - 8) + 7;
                int NT = klast - kr0 + 1; NT += (NT & 1);
                {
                    LAS float* btab = (LAS float*)(ldsl + att::SHM_BIAS);
                    const float* rpb = kp()->na_rpb + ((size_t)j * 16 + h) * 465;
                    for (int u = tid_fresh(wave_s); u < 15 * 128; u += NTHREADS) { const int dr = u >> 7; int d = (u & 127) - 48; d = d < 0 ? 0 : (d > 30 ? 30 : d); btab[u] = rpb[dr * 31 + d] * (1.f / att::SCALE); }
                }
                unsigned char* ws = kp()->ws;
                const bf16_t* base = (const bf16_t*)(ws + WS_BIG) + (size_t)b * SEQ * NA_N + h * HD;
                att::attn_body<true, NA_N, DM>(base + (size_t)r0 * GRID_W * NA_N, base + DM + (size_t)kr0 * GRID_W * NA_N, base + 2 * DM + (size_t)kr0 * GRID_W * NA_N,
                                               ACTM_ + ((size_t)b * SEQ + r0 * GRID_W) * DM + h * HD, NT, (char*)lds, r0, kr0, (const float*)(lds + att::SHM_BIAS), wave_s);
            }
        } else if (mixer == 1) {
            unsigned char* ws = kp()->ws;
            sc_conv_phase((const bf16_t*)(ws + WS_BIG), kp()->sc_conv_w, ACTM_, LGTID_, LGTHR_, TOK0_);
        } else {
            gqa_prep_phase(BIGG_, kp()->gqa_q_norm, kp()->gqa_k_norm, LGW_, LNGW_, LANE_, TOK0_);
            XBAR();
            for (int i = 0; i < 4; ++i) {
                const int w = VR_, b = VX_, kvh = i, h = kvh * 4 + (w >> 3), qb = w & 7;
                unsigned char* ws = kp()->ws;
                const bf16_t* base = BIGG_ + (size_t)b * SEQ * GQ_N;
                att::attn_body<false, GQ_N, DM>(base + (size_t)qb * 256 * GQ_N + h * HD, base + DM + kvh * HD, base + DM + 512 + kvh * HD,
                                                ACTM_ + ((size_t)b * SEQ + qb * 256) * DM + h * HD, SEQ / 64, (char*)lds, 0, 0, nullptr, wave_s);
            }
        }
        XBAR();
        {
            unsigned char* ws = kp()->ws;
            const bf16_t* Wt = mixer == 0 ? (const bf16_t*)(ws + WS_NAO + j * SZ_W2048) : mixer == 1 ? (const bf16_t*)(ws + WS_SCOUT) : (const bf16_t*)(ws + WS_GO);
            pg8::Gemm g{(const bf16_t*)ACTM_, Wt, MT, DM, DM, (size_t)256 * DM * 2, (size_t)128 * DM * 2}; pg8::StaticOrder S; S.init(DM, VX_, VR_);
            pg8::EpiRes E{(bf16_t*)(ws + WS_XH), DM, (float*)(ws + WS_SLOT) + (size_t)(2 * layer + 1) * 32 * MT, nullptr};
            pg8::gemm_phase<pg8::EpiRes>(ldsl, g, S, E, wave_s);
        }
        XBAR();
        rstd_pass((const float*)(kp()->ws + WS_SLOT) + (size_t)(2 * layer + 1) * 32 * MT, (float*)(kp()->ws + WS_RSTD) + (size_t)(2 * layer + 1) * MT, LGTID_, LGTHR_, TOK0_);
        XBAR();
        {
            unsigned char* ws = kp()->ws;
            pg8::Gemm g{(const bf16_t*)(ws + WS_XH), (const bf16_t*)(ws + WS_UP + layer * SZ_WUP), MT, UP_N, DM, (size_t)128 * DM * 2, (size_t)DFF * DM * 2}; pg8::StaticOrder S; S.init(UP_N, VX_, VR_);
            pg8::EpiGlu E{(bf16_t*)(ws + WS_ACT), (bf16_t*)(ws + WS_RAW), kp()->ffn_conv_w + (size_t)layer * 3 * UP_N, kp()->ffn_conv_b + (size_t)layer * UP_N, (const float*)(ws + WS_RSTD) + (size_t)(2 * layer + 1) * MT};
            pg8::gemm_phase<pg8::EpiGlu>(ldsl, g, S, E, wave_s);
        }
        XBAR();
        glu_fix_phase((const bf16_t*)(kp()->ws + WS_RAW), kp()->ffn_conv_w + (size_t)layer * 3 * UP_N, kp()->ffn_conv_b + (size_t)layer * UP_N, (bf16_t*)(kp()->ws + WS_ACT), LGTID_, LGTHR_, VX_ * (SEQ / 64));
        XBAR();
        {
            unsigned char* ws = kp()->ws;
            pg8::Gemm g{(const bf16_t*)(ws + WS_ACT), (const bf16_t*)(ws + WS_DN + layer * SZ_WDN), MT, DM, DFF, (size_t)256 * DFF * 2, (size_t)128 * DFF * 2}; pg8::StaticOrder S; S.init(DM, VX_, VR_);
            pg8::EpiRes E{(bf16_t*)(ws + WS_XH), DM, (float*)(ws + WS_SLOT) + (size_t)(2 * layer + 2) * 32 * MT, nullptr};
            pg8::gemm_phase<pg8::EpiRes>(ldsl, g, S, E, wave_s);
        }
        XBAR();
        if (layer + 1 < DEPTH) { rstd_pass((const float*)(kp()->ws + WS_SLOT) + (size_t)(2 * layer + 2) * 32 * MT, (float*)(kp()->ws + WS_RSTD) + (size_t)(2 * layer + 2) * MT, LGTID_, LGTHR_, TOK0_); }
    }
    rmsnorm_rows_f32((const bf16_t*)(kp()->ws + WS_XH), kp()->final_norm, kp()->out, LGW_, LNGW_, LANE_, TOK0_);
}

extern "C" void kernel_launch(void* const* d_in, const int* in_sizes, int n_in, void* d_out, int out_size, void* d_ws, size_t ws_size, hipStream_t stream) {
    static int grid_blocks = 0;
    if (grid_blocks == 0) {
        if (n_in != 18 || in_sizes[0] != MT * DM || out_size != MT * DM || ws_size < WS_END) {
            fprintf(stderr, "kernel_launch: unexpected shapes (n_in %d, in0 %d, out %d, ws %zu need %zu); nothing launched\n", n_in, n_in > 0 ? in_sizes[0] : -1, out_size, ws_size, (size_t)WS_END);
            grid_blocks = -1; return; }
        int dev = 0, cus = 0, per_cu = 0;
        (void)hipGetDevice(&dev);
        (void)hipDeviceGetAttribute(&cus, hipDeviceAttributeMultiprocessorCount, dev);
        if (hipFuncSetAttribute((const void*)fwd_megakernel, hipFuncAttributeMaxDynamicSharedMemorySize, LDS_BYTES) != hipSuccess) { fprintf(stderr, "kernel_launch: hipFuncSetAttribute failed\n"); grid_blocks = -1; return; }
        if (hipOccupancyMaxActiveBlocksPerMultiprocessor(&per_cu, (const void*)fwd_megakernel, NTHREADS, LDS_BYTES) != hipSuccess || per_cu < 1) { fprintf(stderr, "kernel_launch: occupancy query gave %d\n", per_cu); per_cu = 1; }
        (void)hipGetLastError();
        if (cus != 256) { fprintf(stderr, "kernel_launch: built for a 256-CU device, found %d CUs; nothing launched\n", cus); grid_blocks = -1; return; }
        grid_blocks = cus * 1;
        fprintf(stderr, "kernel_launch: cus %d per_cu %d grid %d\n", cus, per_cu, grid_blocks);
    }
    if (grid_blocks < 0) return;
    Params p{};
    p.x = (const float*)d_in[0]; p.mix_norm = (const float*)d_in[1]; p.ffn_norm = (const float*)d_in[2]; p.final_norm = (const float*)d_in[3];
    p.na_w_qkv = (const float*)d_in[4]; p.na_rpb = (const float*)d_in[5]; p.na_w_o = (const float*)d_in[6];
    p.sc_w_in = (const float*)d_in[7]; p.sc_conv_w = (const float*)d_in[8]; p.sc_w_out = (const float*)d_in[9];
    p.gqa_w_qkv = (const float*)d_in[10]; p.gqa_q_norm = (const float*)d_in[11]; p.gqa_k_norm = (const float*)d_in[12]; p.gqa_w_o = (const float*)d_in[13];
    p.ffn_w_up = (const float*)d_in[14]; p.ffn_conv_w = (const float*)d_in[15]; p.ffn_conv_b = (const float*)d_in[16]; p.ffn_w_down = (const float*)d_in[17];
    p.out = (float*)d_out; p.ws = (unsigned char*)d_ws;
    if (hipMemsetAsync((char*)d_ws + WS_CTL, 0, CTL_BYTES, stream) != hipSuccess) { fprintf(stderr, "kernel_launch: memset failed\n"); return; }
    void* args[] = {&p};
    hipError_t e = hipLaunchCooperativeKernel((const void*)fwd_megakernel, dim3(grid_blocks), dim3(NTHREADS), args, LDS_BYTES, stream);
    if (e != hipSuccess) fprintf(stderr, "cooperative launch failed: %s (grid %d)\n", hipGetErrorString(e), grid_blocks);
}
```
